# Optimizing an MI355X kernel written in HIP

```python
import jax, jax.numpy as jnp
from jax import lax
import numpy as np

D_MODEL = 2048
BATCH = 2
SEQ = 8192
DEPTH = 1
DEC_BATCH = 32
DEC_SEQ = 64
PAST_LEN = 4096

CHUNK = 64
Q_BLOCK = 128
SB_HEADS = 16
SB_HEAD_DIM = 64
SB_WIDTH = SB_HEADS * SB_HEAD_DIM
RW_HEADS = 16
RW_HEAD_DIM = 64
RW_WIDTH = RW_HEADS * RW_HEAD_DIM
DECAY_LORA = 96
ICLR_LORA = 96
GATE_LORA = 256
RW_COLS = 3 * RW_WIDTH + DECAY_LORA + ICLR_LORA + GATE_LORA
IN_COLS = 3 * SB_WIDTH + RW_COLS + 2 * D_MODEL
D_FF = 5632
NORM_EPS = 1e-6
GN_EPS = 64e-5

P_SPLITS = [SB_WIDTH, 2 * SB_WIDTH, 3 * SB_WIDTH, 3 * SB_WIDTH + RW_COLS, 3 * SB_WIDTH + RW_COLS + D_MODEL]
RW_SPLITS = [RW_WIDTH, 2 * RW_WIDTH, 3 * RW_WIDTH, 3 * RW_WIDTH + DECAY_LORA, 3 * RW_WIDTH + DECAY_LORA + ICLR_LORA]

kernel_name = 'stickbreak_rwkv7_macaron_stream_step'


def rms_norm(x, g, eps=NORM_EPS):
    xf = x.astype(jnp.float32)
    y = xf * lax.rsqrt(jnp.mean(xf * xf, axis=-1, keepdims=True) + eps)
    return (y * g.astype(jnp.float32)).astype(x.dtype)


def swiglu(x, w_gate, w_up, w_down):
    return (jax.nn.silu(x @ w_gate) * (x @ w_up)) @ w_down


def sb_block(q, q_pos, k, v, k_pos):
    f32 = jnp.float32
    z = jnp.einsum('qhd,khd->hqk', q.astype(f32), k.astype(f32)) * (SB_HEAD_DIM ** -0.5)
    mask = (k_pos[None, :] < q_pos[:, None])[None]
    log_beta = jax.nn.log_sigmoid(z)
    log_keep = jnp.where(mask, jax.nn.log_sigmoid(-z), 0.0)
    tail = lax.cumsum(log_keep, axis=2, reverse=True) - log_keep
    w = jnp.where(mask, jnp.exp(log_beta + tail), 0.0)
    return jnp.einsum('hqk,khd->qhd', w, v.astype(f32)).astype(v.dtype)


def stick_breaking(q, k, v, past_k, past_v):
    B, T, H, Dh = q.shape
    if past_k is None:
        keys, vals, P = k, v, 0
    else:
        P = past_k.shape[1]
        keys = jnp.concatenate([past_k.astype(k.dtype), k], axis=1)
        vals = jnp.concatenate([past_v.astype(v.dtype), v], axis=1)
    k_pos = jnp.arange(P + T)
    q_pos = P + jnp.arange(T)
    qb = min(T, Q_BLOCK)
    nb = T // qb
    pos_blk = q_pos.reshape(nb, qb)

    def per_stream(args):
        q_s, k_s, v_s = args
        q_blk = q_s.reshape(nb, qb, H, Dh)
        o = lax.map(lambda a: sb_block(a[0], a[1], k_s, v_s, k_pos), (q_blk, pos_blk))
        return o.reshape(T, H, Dh)

    return lax.map(per_stream, (q, keys, vals))


def rwkv_scan(r, decay, k, v, a_vec, b_vec, s0):
    xs = tuple(jnp.moveaxis(t.astype(jnp.float32), 1, 0) for t in (r, decay, k, v, a_vec, b_vec))

    def step(S, inp):
        r_t, w_t, k_t, v_t, a_t, b_t = inp
        sa = jnp.einsum('bhij,bhj->bhi', S, a_t)
        S = S * w_t[:, :, None, :] + sa[..., None] * b_t[:, :, None, :] + v_t[..., None] * k_t[:, :, None, :]
        return S, jnp.einsum('bhij,bhj->bhi', S, r_t)

    S, ys = lax.scan(step, s0.astype(jnp.float32), xs)
    return jnp.moveaxis(ys, 0, 1), S


def rwkv7_mixer(p, prev_row, wkv0, lw):
    B, T, _ = p.shape
    H, N = RW_HEADS, RW_HEAD_DIM
    f32 = jnp.float32
    pf = p.astype(f32)
    shifted = jnp.concatenate([prev_row.astype(f32), pf[:, :-1]], axis=1)
    xm = pf + (shifted - pf) * lw['rwkv_mu'].astype(f32)
    r, k, v, wl, al, gl = jnp.split(xm, RW_SPLITS, axis=-1)
    w_log = -jax.nn.softplus(-(lw['rwkv_w0'] + jnp.tanh(wl) @ lw['rwkv_w_w2'])) - 0.5
    decay = jnp.exp(-jnp.exp(w_log))
    a = jax.nn.sigmoid(lw['rwkv_a0'] + al @ lw['rwkv_w_a2'])
    g = jax.nn.sigmoid(gl) @ lw['rwkv_w_g2']
    kk = k * lw['rwkv_k_k']
    k = k * (1.0 + (a - 1.0) * lw['rwkv_k_a'])
    hd = lambda t: t.reshape(B, T, H, N)
    r, k, v, kk, a, decay = hd(r), hd(k), hd(v), hd(kk), hd(a), hd(decay)
    kk = kk / jnp.maximum(jnp.linalg.norm(kk, axis=-1, keepdims=True), 1e-12)
    y, S = rwkv_scan(r, decay, k, v, -kk, kk * a, wkv0)
    mu = jnp.mean(y, axis=-1, keepdims=True)
    var = jnp.mean(jnp.square(y - mu), axis=-1, keepdims=True)
    y = ((y - mu) * lax.rsqrt(var + GN_EPS)).reshape(B, T, RW_WIDTH) * lw['rwkv_ln_w'] + lw['rwkv_ln_b']
    bonus = jnp.sum(r * k * lw['rwkv_r_k'], axis=-1, keepdims=True) * v
    y = (y + bonus.reshape(B, T, RW_WIDTH)) * g
    return y.astype(p.dtype) @ lw['rwkv_w_o'], S, p[:, -1:]


def trunk_layer(x, past_k, past_v, wkv0, shift0, lw):
    B, T, _ = x.shape
    h = x + 0.5 * swiglu(rms_norm(x, lw['ffn1_norm']), lw['ffn1_w_gate'], lw['ffn1_w_up'], lw['ffn1_w_down'])
    n = rms_norm(h, lw['mix_norm'])
    p = n @ lw['w_in']
    q, k, v, p_rw, gate_sb, gate_rw = jnp.split(p, P_SPLITS, axis=-1)
    q = rms_norm(q.reshape(B, T, SB_HEADS, SB_HEAD_DIM), lw['sb_q_norm'])
    k = rms_norm(k.reshape(B, T, SB_HEADS, SB_HEAD_DIM), lw['sb_k_norm'])
    v = v.reshape(B, T, SB_HEADS, SB_HEAD_DIM)
    o_sb = stick_breaking(q, k, v, past_k, past_v).reshape(B, T, SB_WIDTH) @ lw['sb_w_o']
    o_rw, wkv, shift = rwkv7_mixer(p_rw, shift0, wkv0, lw)
    merged = jax.nn.sigmoid(gate_sb) * o_sb + jax.nn.sigmoid(gate_rw) * o_rw
    h = h + merged @ lw['w_out']
    h = h + 0.5 * swiglu(rms_norm(h, lw['ffn2_norm']), lw['ffn2_w_gate'], lw['ffn2_w_up'], lw['ffn2_w_down'])
    return h, k, v, wkv.astype(x.dtype), shift


def setup_inputs(seed: int = 0) -> dict:
    key = jax.random.key(seed)
    ks = iter(jax.random.split(key, 48))

    def nrm(shape, scale):
        return jax.random.normal(next(ks), shape, jnp.float32) * scale

    def dense(fan_in, fan_out, gain=1.0):
        return nrm((DEPTH, fan_in, fan_out), gain * fan_in ** -0.5)

    def gain_vec(n):
        return 1.0 + nrm((DEPTH, n), 0.05)

    return {
        'x_prompt': nrm((BATCH, SEQ, D_MODEL), 1.0),
        'x_sample': nrm((DEC_BATCH, DEC_SEQ, D_MODEL), 1.0),
        'cache_sb_k': nrm((DEPTH, DEC_BATCH, PAST_LEN, SB_HEADS, SB_HEAD_DIM), 1.0),
        'cache_sb_v': nrm((DEPTH, DEC_BATCH, PAST_LEN, SB_HEADS, SB_HEAD_DIM), 1.0),
        'state_rwkv_wkv': nrm((DEPTH, DEC_BATCH, RW_HEADS, RW_HEAD_DIM, RW_HEAD_DIM), 0.1),
        'state_rwkv_shift': nrm((DEPTH, DEC_BATCH, 1, RW_COLS), 1.0),
        'ffn1_norm': gain_vec(D_MODEL),
        'ffn1_w_gate': dense(D_MODEL, D_FF),
        'ffn1_w_up': dense(D_MODEL, D_FF),
        'ffn1_w_down': dense(D_FF, D_MODEL),
        'mix_norm': gain_vec(D_MODEL),
        'w_in': dense(D_MODEL, IN_COLS),
        'sb_q_norm': gain_vec(SB_HEAD_DIM),
        'sb_k_norm': gain_vec(SB_HEAD_DIM),
        'sb_w_o': dense(SB_WIDTH, D_MODEL),
        'rwkv_mu': jax.random.uniform(next(ks), (DEPTH, RW_COLS), jnp.float32),
        'rwkv_w0': nrm((DEPTH, RW_WIDTH), 0.5),
        'rwkv_w_w2': dense(DECAY_LORA, RW_WIDTH, 0.5),
        'rwkv_a0': nrm((DEPTH, RW_WIDTH), 0.1),
        'rwkv_w_a2': dense(ICLR_LORA, RW_WIDTH, 0.5),
        'rwkv_w_g2': dense(GATE_LORA, RW_WIDTH),
        'rwkv_k_k': 0.85 + nrm((DEPTH, RW_WIDTH), 0.05),
        'rwkv_k_a': gain_vec(RW_WIDTH),
        'rwkv_r_k': nrm((DEPTH, RW_HEADS, RW_HEAD_DIM), 0.1),
        'rwkv_ln_w': gain_vec(RW_WIDTH),
        'rwkv_ln_b': nrm((DEPTH, RW_WIDTH), 0.02),
        'rwkv_w_o': dense(RW_WIDTH, D_MODEL),
        'w_out': dense(D_MODEL, D_MODEL),
        'ffn2_norm': gain_vec(D_MODEL),
        'ffn2_w_gate': dense(D_MODEL, D_FF),
        'ffn2_w_up': dense(D_MODEL, D_FF),
        'ffn2_w_down': dense(D_FF, D_MODEL),
    }


def reference(x_prompt, x_sample, cache_sb_k, cache_sb_v, state_rwkv_wkv, state_rwkv_shift,
              ffn1_norm, ffn1_w_gate, ffn1_w_up, ffn1_w_down, mix_norm, w_in,
              sb_q_norm, sb_k_norm, sb_w_o,
              rwkv_mu, rwkv_w0, rwkv_w_w2, rwkv_a0, rwkv_w_a2, rwkv_w_g2, rwkv_k_k, rwkv_k_a,
              rwkv_r_k, rwkv_ln_w, rwkv_ln_b, rwkv_w_o, w_out,
              ffn2_norm, ffn2_w_gate, ffn2_w_up, ffn2_w_down):
    yp, ys = x_prompt, x_sample
    bp = x_prompt.shape[0]
    kp_l, vp_l, wkvp_l, shp_l = [], [], [], []
    ks_l, vs_l, wkvs_l, shs_l = [], [], [], []
    for l in range(DEPTH):
        lw = {
            'ffn1_norm': ffn1_norm[l], 'ffn1_w_gate': ffn1_w_gate[l], 'ffn1_w_up': ffn1_w_up[l], 'ffn1_w_down': ffn1_w_down[l],
            'mix_norm': mix_norm[l], 'w_in': w_in[l],
            'sb_q_norm': sb_q_norm[l], 'sb_k_norm': sb_k_norm[l], 'sb_w_o': sb_w_o[l],
            'rwkv_mu': rwkv_mu[l], 'rwkv_w0': rwkv_w0[l], 'rwkv_w_w2': rwkv_w_w2[l], 'rwkv_a0': rwkv_a0[l],
            'rwkv_w_a2': rwkv_w_a2[l], 'rwkv_w_g2': rwkv_w_g2[l], 'rwkv_k_k': rwkv_k_k[l], 'rwkv_k_a': rwkv_k_a[l],
            'rwkv_r_k': rwkv_r_k[l], 'rwkv_ln_w': rwkv_ln_w[l], 'rwkv_ln_b': rwkv_ln_b[l], 'rwkv_w_o': rwkv_w_o[l],
            'w_out': w_out[l],
            'ffn2_norm': ffn2_norm[l], 'ffn2_w_gate': ffn2_w_gate[l], 'ffn2_w_up': ffn2_w_up[l], 'ffn2_w_down': ffn2_w_down[l],
        }
        wkv_zero = jnp.zeros((bp, RW_HEADS, RW_HEAD_DIM, RW_HEAD_DIM), jnp.float32)
        shift_zero = jnp.zeros((bp, 1, RW_COLS), yp.dtype)
        yp, kp, vp, wkvp, shp = trunk_layer(yp, None, None, wkv_zero, shift_zero, lw)
        ys, kn, vn, wkvn, shn = trunk_layer(ys, cache_sb_k[l], cache_sb_v[l], state_rwkv_wkv[l], state_rwkv_shift[l], lw)
        kp_l.append(kp); vp_l.append(vp); wkvp_l.append(wkvp); shp_l.append(shp)
        ks_l.append(kn); vs_l.append(vn); wkvs_l.append(wkvn); shs_l.append(shn)
    new_sb_k_prompt = jnp.stack(kp_l)
    new_sb_v_prompt = jnp.stack(vp_l)
    new_wkv_prompt = jnp.stack(wkvp_l)
    new_shift_prompt = jnp.stack(shp_l)
    new_sb_k_sample = jnp.stack(ks_l)
    new_sb_v_sample = jnp.stack(vs_l)
    new_wkv_sample = jnp.stack(wkvs_l)
    new_shift_sample = jnp.stack(shs_l)
    return (yp, ys, new_sb_k_prompt, new_sb_v_prompt, new_wkv_prompt, new_shift_prompt,
            new_sb_k_sample, new_sb_v_sample, new_wkv_sample, new_shift_sample)
```

```cpp
#include <hip/hip_runtime.h>
#include <cstdio>
#include <cstdint>
namespace pg8 {
#define PG8_LAS __attribute__((address_space(3)))
typedef unsigned short bf16_t;
typedef short bf16x8 __attribute__((ext_vector_type(8)));
typedef float f32x4 __attribute__((ext_vector_type(4)));
typedef unsigned u32x4 __attribute__((ext_vector_type(4)));
constexpr int BM = 256, BK = 64, HALF = 128, HTB = HALF * BK * 2  , STAGE_BYTES = 8 * HTB, NXCD = 8, WGM = 8;

__host__ __device__ __forceinline__ int lds_byte(int r, int c) { const int st = (r >> 4) * 2 + (c >> 5), rr = r & 15, cc = c & 31, ob = rr * 64 + cc * 2; return st * 1024 + (ob ^ (((ob >> 9) & 1) << 5)); }
__host__ __device__ __forceinline__ void stage_rc(int b, int& R, int& C) { const int st = b / 1024, sb = b % 1024, swz = sb ^ (((sb >> 9) & 1) << 5); R = (st >> 1) * 16 + swz / 64; C = (st & 1) * 32 + (swz % 64) / 2; }
__host__ __device__ __forceinline__ int perm32(int rho) { const int n = rho >> 4, i = rho & 15; return 8 * (i >> 2) + 4 * n + (i & 3); }

struct Unit { int pm, pn; };
struct Gemm { const bf16_t* A; const bf16_t* Bt; int M, N, K; };

struct StaticOrder {
    int nM, nN, nwg, G, c;
    __host__ __device__ void init(int M, int N, int G_, int c_) { nM = M / BM; nN = N / BM; nwg = nM * nN; G = G_; c = c_; }
    __host__ __device__ bool next(int i, Unit& u) const {
        const long L = (long)i * G + c; if (L >= nwg) return false;
        int wgid = (int)L; { const int q = nwg / NXCD, r = nwg % NXCD, xcd = wgid % NXCD, off = wgid / NXCD; wgid = (xcd < r ? xcd * (q + 1) : r * (q + 1) + (xcd - r) * q) + off; }
        const int nig = WGM * nN, gid = wgid / nig, fm = gid * WGM, gsz = (nM - fm) < WGM ? (nM - fm) : WGM;
        u.pm = fm + ((wgid % nig) % gsz); u.pn = (wgid % nig) / gsz; return true;
    }
    __device__ __forceinline__ void a_ready(const Unit&) const {}
    __device__ __forceinline__ void done(const Unit&) const {}
};

typedef float f32x2_t __attribute__((ext_vector_type(2))); typedef __bf16 bf16x2_t __attribute__((ext_vector_type(2)));
__device__ __forceinline__ unsigned cvt_pk_bf16(float lo, float hi) { const f32x2_t v = {lo, hi}; const bf16x2_t b = __builtin_convertvector(v, bf16x2_t); return __builtin_bit_cast(unsigned, b); }
__device__ __forceinline__ u32x4 pack8(const f32x4 a, const f32x4 b) { u32x4 w; w.x = cvt_pk_bf16(a[0], a[1]); w.y = cvt_pk_bf16(a[2], a[3]); w.z = cvt_pk_bf16(b[0], b[1]); w.w = cvt_pk_bf16(b[2], b[3]); return w; }
__device__ __forceinline__ float bflo(unsigned w) { return __uint_as_float(w << 16); }
__device__ __forceinline__ float bfhi(unsigned w) { return __uint_as_float(w & 0xffff0000u); }
__device__ __forceinline__ void unpack8(const u32x4 w, f32x4& a, f32x4& b) { a = (f32x4){bflo(w.x), bfhi(w.x), bflo(w.y), bfhi(w.y)}; b = (f32x4){bflo(w.z), bfhi(w.z), bflo(w.w), bfhi(w.w)}; }
__device__ __forceinline__ float sigm(float x) { return 1.0f / (1.0f + __expf(-x)); }
__device__ __forceinline__ f32x4 sigm4(const f32x4 x) { return (f32x4){sigm(x[0]), sigm(x[1]), sigm(x[2]), sigm(x[3])}; }
constexpr int MP = 16384;

struct EpiGateUp {
    static constexpr bool PERM = true, AFTER_DRAIN = false;
    bf16_t* H; int ldh;
    __device__ __forceinline__ void operator()(const f32x4 (&acc)[2][2][4][2], const Unit& u, int wr, int wc, int fr, int fq) const {
        const int row0 = u.pm * BM + wr * 64 + fr, col0 = u.pn * 128 + wc * 32 + 8 * fq;
#pragma unroll
        for (int ai = 0; ai < 2; ++ai)
#pragma unroll
            for (int m = 0; m < 4; ++m) { bf16_t* rowp = H + (size_t)(row0 + ai * HALF + m * 16) * ldh + col0;
                const f32x4 g0 = acc[ai][0][m][0], g1 = acc[ai][0][m][1], u0 = acc[ai][1][m][0], u1 = acc[ai][1][m][1];
                const f32x4 h0 = g0 * sigm4(g0) * u0, h1 = g1 * sigm4(g1) * u1;
                *(u32x4*)rowp = pack8(h0, h1); }
    }
};
struct EpiResid {
    static constexpr bool PERM = false, AFTER_DRAIN = false;
    const float* b0; const float* b1; float* out; int ld; float scale;
    __device__ __forceinline__ void operator()(const f32x4 (&acc)[2][2][4][2], const Unit& u, int wr, int wc, int fr, int fq) const {
        const float* base = (u.pm * BM < MP) ? b0 : b1;
        const int row0 = u.pm * BM + wr * 64 + fr, col0 = u.pn * BM + wc * 32 + 4 * fq;
#pragma unroll
        for (int ai = 0; ai < 2; ++ai)
#pragma unroll
            for (int m = 0; m < 4; ++m) { const size_t off = (size_t)(row0 + ai * HALF + m * 16) * ld + col0;
#pragma unroll
                for (int bj = 0; bj < 2; ++bj)
#pragma unroll
                    for (int n = 0; n < 2; ++n) { const f32x4 bs = *(const f32x4*)(base + off + bj * HALF + n * 16); *(f32x4*)(out + off + bj * HALF + n * 16) = bs + acc[ai][bj][m][n] * scale; }
                if (m & 1) asm volatile("" ::: "memory"); }
    }
};
struct EpiWin {
    static constexpr bool PERM = true, AFTER_DRAIN = false;
    bf16_t* Qb; float* Kp; float* Ks; float* Vp; float* Vs; bf16_t* PRW; bf16_t* GSB; bf16_t* GRW; float* SHp; float* SHs; const float* qg; const float* kg;
    __device__ __forceinline__ void operator()(const f32x4 (&acc)[2][2][4][2], const Unit& u, int wr, int wc, int fr, int fq) const {
        const int pn = u.pn, rowb = u.pm * BM + wr * 64 + fr; const bool prompt = u.pm * BM < MP;
        if (pn < 8) {
            const bool isq = pn < 4; const int head = 4 * (pn & 3) + wc; const float* gain = isq ? qg : kg;
            f32x4 gv[2][2];
#pragma unroll
            for (int bj = 0; bj < 2; ++bj)
#pragma unroll
                for (int n = 0; n < 2; ++n) gv[bj][n] = *(const f32x4*)(gain + 32 * bj + 8 * fq + 4 * n);
#pragma unroll
            for (int ai = 0; ai < 2; ++ai)
#pragma unroll
                for (int m = 0; m < 4; ++m) { const int row = rowb + ai * HALF + m * 16; float ss = 0.f;
#pragma unroll
                    for (int bj = 0; bj < 2; ++bj)
#pragma unroll
                        for (int n = 0; n < 2; ++n) { const f32x4 x = acc[ai][bj][m][n]; ss += (x[0] * x[0] + x[1] * x[1]) + (x[2] * x[2] + x[3] * x[3]); }
                    ss += __shfl_xor(ss, 16); ss += __shfl_xor(ss, 32);
                    float rs = 1.0f / sqrtf(ss * (1.0f / 64.0f) + 1e-6f); if (isq) rs *= 0.125f;
#pragma unroll
                    for (int bj = 0; bj < 2; ++bj) { const f32x4 v0 = acc[ai][bj][m][0] * gv[bj][0] * rs, v1 = acc[ai][bj][m][1] * gv[bj][1] * rs; const int col = head * 64 + 32 * bj + 8 * fq;
                        if (isq) *(u32x4*)(Qb + (size_t)row * 1024 + col) = pack8(v0, v1);
                        else { float* kp = (prompt ? Kp + (size_t)row * 1024 : Ks + (size_t)(row - MP) * 1024) + col; *(f32x4*)kp = v0; *(f32x4*)(kp + 4) = v1; } } }
        } else if (pn < 12) {
#pragma unroll
            for (int ai = 0; ai < 2; ++ai)
#pragma unroll
                for (int m = 0; m < 4; ++m) { const int row = rowb + ai * HALF + m * 16;
#pragma unroll
                    for (int bj = 0; bj < 2; ++bj) { const int col = (pn - 8) * 256 + bj * HALF + wc * 32 + 8 * fq; float* vp = (prompt ? Vp + (size_t)row * 1024 : Vs + (size_t)(row - MP) * 1024) + col;
                        *(f32x4*)vp = acc[ai][bj][m][0]; *(f32x4*)(vp + 4) = acc[ai][bj][m][1]; } }
        } else if (pn < 26) {
#pragma unroll
            for (int ai = 0; ai < 2; ++ai)
#pragma unroll
                for (int m = 0; m < 4; ++m) { const int row = rowb + ai * HALF + m * 16;
                    const bool last = prompt ? ((row & 8191) == 8191) : ((row & 63) == 63);
#pragma unroll
                    for (int bj = 0; bj < 2; ++bj) { const int col = (pn - 12) * 256 + bj * HALF + wc * 32 + 8 * fq;
                        *(u32x4*)(PRW + (size_t)row * 3584 + col) = pack8(acc[ai][bj][m][0], acc[ai][bj][m][1]);
                        if (last && col < 3520) { float* sp = (prompt ? SHp + (size_t)(row >> 13) * 3520 : SHs + (size_t)((row - MP) >> 6) * 3520) + col; *(f32x4*)sp = acc[ai][bj][m][0]; *(f32x4*)(sp + 4) = acc[ai][bj][m][1]; } } }
        } else {
            bf16_t* G = pn < 34 ? GSB : GRW; const int t0 = pn < 34 ? 26 : 34;
#pragma unroll
            for (int ai = 0; ai < 2; ++ai)
#pragma unroll
                for (int m = 0; m < 4; ++m) { const int row = rowb + ai * HALF + m * 16;
#pragma unroll
                    for (int bj = 0; bj < 2; ++bj) { const int col = (pn - t0) * 256 + bj * HALF + wc * 32 + 8 * fq;
                        *(u32x4*)(G + (size_t)row * 2048 + col) = pack8(sigm4(acc[ai][bj][m][0]), sigm4(acc[ai][bj][m][1])); } }
        }
    }
};
struct EpiLora {
    static constexpr bool PERM = true, AFTER_DRAIN = false;
    float* WD; bf16_t* KP; bf16_t* KKN; bf16_t* BV; bf16_t* G; const bf16_t* XK; const float* w0; const float* a0; const float* k_k; const float* k_a;
    __device__ __forceinline__ void operator()(const f32x4 (&acc)[2][2][4][2], const Unit& u, int wr, int wc, int fr, int fq) const {
        const int pn = u.pn, type = pn >> 2, head = 4 * (pn & 3) + wc, rowb = u.pm * BM + wr * 64 + fr, colh = head * 64 + 8 * fq;
        if (type == 0) {
            f32x4 wv[2][2];
#pragma unroll
            for (int bj = 0; bj < 2; ++bj)
#pragma unroll
                for (int n = 0; n < 2; ++n) wv[bj][n] = *(const f32x4*)(w0 + colh + 32 * bj + 4 * n);
#pragma unroll
            for (int ai = 0; ai < 2; ++ai)
#pragma unroll
                for (int m = 0; m < 4; ++m) { const int row = rowb + ai * HALF + m * 16;
#pragma unroll
                    for (int bj = 0; bj < 2; ++bj)
#pragma unroll
                        for (int n = 0; n < 2; ++n) { const f32x4 x = acc[ai][bj][m][n] + wv[bj][n]; f32x4 d;
#pragma unroll
                            for (int e = 0; e < 4; ++e) { const float nx = -x[e]; const float sp = fmaxf(nx, 0.f) + __logf(1.0f + __expf(-fabsf(nx))); d[e] = __expf(-__expf(-sp - 0.5f)); }
                            *(f32x4*)(WD + (size_t)row * 1024 + colh + 32 * bj + 4 * n) = d; } }
        } else if (type == 1) {
#pragma unroll
            for (int ai = 0; ai < 2; ++ai)
#pragma unroll
                for (int m = 0; m < 4; ++m) { const int row = rowb + ai * HALF + m * 16; f32x4 al[2][2], kk[2][2]; float ss = 0.f;
                    asm volatile("" ::: "memory");
#pragma unroll
                    for (int bj = 0; bj < 2; ++bj) { f32x4 xk[2]; unpack8(*(const u32x4*)(XK + (size_t)row * 1024 + colh + 32 * bj), xk[0], xk[1]); f32x4 kp[2];
#pragma unroll
                        for (int n = 0; n < 2; ++n) { const int cc = colh + 32 * bj + 4 * n;
                            al[bj][n] = sigm4(acc[ai][bj][m][n] + *(const f32x4*)(a0 + cc)); kk[bj][n] = xk[n] * *(const f32x4*)(k_k + cc); kp[n] = xk[n] * (1.0f + (al[bj][n] - 1.0f) * *(const f32x4*)(k_a + cc));
                            const f32x4 q = kk[bj][n]; ss += (q[0] * q[0] + q[1] * q[1]) + (q[2] * q[2] + q[3] * q[3]); }
                        *(u32x4*)(KP + (size_t)row * 1024 + colh + 32 * bj) = pack8(kp[0], kp[1]); }
                    ss += __shfl_xor(ss, 16); ss += __shfl_xor(ss, 32);
                    const float inv = 1.0f / fmaxf(sqrtf(ss), 1e-12f);
#pragma unroll
                    for (int bj = 0; bj < 2; ++bj) { const size_t off = (size_t)row * 1024 + colh + 32 * bj; const f32x4 n0 = kk[bj][0] * inv, n1 = kk[bj][1] * inv;
                        *(u32x4*)(KKN + off) = pack8(n0, n1); *(u32x4*)(BV + off) = pack8(n0 * al[bj][0], n1 * al[bj][1]); } }
        } else {
#pragma unroll
            for (int ai = 0; ai < 2; ++ai)
#pragma unroll
                for (int m = 0; m < 4; ++m) { const int row = rowb + ai * HALF + m * 16;
#pragma unroll
                    for (int bj = 0; bj < 2; ++bj) *(u32x4*)(G + (size_t)row * 1024 + colh + 32 * bj) = pack8(acc[ai][bj][m][0], acc[ai][bj][m][1]); }
        }
    }
};
template <int STEP> struct EpiMerge {
    static constexpr bool PERM = true, AFTER_DRAIN = false;
    const bf16_t* GATE; float* MPART; bf16_t* MERGED;
    __device__ __forceinline__ void operator()(const f32x4 (&acc)[2][2][4][2], const Unit& u, int wr, int wc, int fr, int fq) const {
        const int row0 = u.pm * BM + wr * 64 + fr, col0 = u.pn * BM + wc * 32 + 8 * fq;
#pragma unroll
        for (int ai = 0; ai < 2; ++ai)
#pragma unroll
            for (int m = 0; m < 4; ++m) { const size_t off = (size_t)(row0 + ai * HALF + m * 16) * 2048 + col0;
#pragma unroll
                for (int bj = 0; bj < 2; ++bj) { f32x4 g0, g1; unpack8(*(const u32x4*)(GATE + off + bj * HALF), g0, g1);
                    f32x4 v0 = g0 * acc[ai][bj][m][0], v1 = g1 * acc[ai][bj][m][1];
                    if (STEP == 1) { *(f32x4*)(MPART + off + bj * HALF) = v0; *(f32x4*)(MPART + off + bj * HALF + 4) = v1; }
                    else { v0 += *(const f32x4*)(MPART + off + bj * HALF); v1 += *(const f32x4*)(MPART + off + bj * HALF + 4); *(u32x4*)(MERGED + off + bj * HALF) = pack8(v0, v1); } }
                if (m & 1) asm volatile("" ::: "memory"); }
    }
};

template <class Epi, class Sched, bool ALIGN_EPI = false, bool SP2 = false>
__device__ __forceinline__ void gemm_phase(PG8_LAS unsigned char* lds, const Gemm g, const Sched& S, const Epi& E) {
    const int tid = threadIdx.x, wid = __builtin_amdgcn_readfirstlane(tid >> 6), lane = tid & 63, wr = wid >> 2, wc = wid & 3, fr = lane & 15, fq = lane >> 4;
    const int K = g.K, nt = K / BK;
    unsigned voffA[2], voffB[2];
#pragma unroll
    for (int i = 0; i < 2; ++i) { int R, C; stage_rc(tid * 16 + i * 8192, R, C); const int Rb = Epi::PERM ? ((R & ~31) + perm32(R & 31)) : R;
        voffA[i] = (unsigned)(R * K + C) * 2u; voffB[i] = (unsigned)(Rb * K + C) * 2u; }
    const size_t kstep = (size_t)(BK * 2);
    const size_t hstep = (size_t)HALF * K * 2;
    const size_t tstep = 2 * hstep;
    const unsigned ldsw = (unsigned)wid * 1024u;
    const int aoff = lds_byte(wr * 64 + fr, fq * 8), boff = lds_byte(wc * 32 + fr, fq * 8);
#define PG8_SA(b, h) (((b) * 2 + (h)) * HTB)
#define PG8_SB(b, h) ((4 + (b) * 2 + (h)) * HTB)
#define PG8_STAGE(bufoff, gbase, voff) do { _Pragma("unroll") for (int _i = 0; _i < 2; ++_i) \
        __builtin_amdgcn_global_load_lds((const unsigned*)((const char*)(gbase) + (voff)[_i]), (PG8_LAS unsigned*)(lds + (bufoff) + ldsw + _i * 8192), 16, 0, 0); } while (0)
#define PG8_LDA(dst, b, h) do { _Pragma("unroll") for (int m = 0; m < 4; ++m) _Pragma("unroll") for (int k = 0; k < 2; ++k) dst[m][k] = *(const PG8_LAS bf16x8*)(lds + PG8_SA(b, h) + aoff + m * 2048 + k * 1024); } while (0)
#define PG8_LDB(dst, b, h) do { _Pragma("unroll") for (int n = 0; n < 2; ++n) _Pragma("unroll") for (int k = 0; k < 2; ++k) dst[n][k] = *(const PG8_LAS bf16x8*)(lds + PG8_SB(b, h) + boff + n * 2048 + k * 1024); } while (0)
#define PG8_MMA(ai, bj, At, Bt) do { __builtin_amdgcn_s_setprio(1); _Pragma("unroll") for (int m = 0; m < 4; ++m) _Pragma("unroll") for (int n = 0; n < 2; ++n) _Pragma("unroll") for (int k = 0; k < 2; ++k) \
        acc[ai][bj][m][n] = __builtin_amdgcn_mfma_f32_16x16x32_bf16(Bt[n][k], At[m][k], acc[ai][bj][m][n], 0, 0, 0); __builtin_amdgcn_s_setprio(0); } while (0)
#define PG8_WAIT_V(n) asm volatile("s_waitcnt vmcnt(" #n ")" ::: "memory")
#define PG8_WAIT_L(n) asm volatile("s_waitcnt lgkmcnt(" #n ")" ::: "memory")
#define PG8_BAR __builtin_amdgcn_s_barrier()
#define PG8_SCHED __builtin_amdgcn_sched_barrier(0)
    Unit cur, nxt; int ui = 0;
    if (!S.next(0, cur)) return;
    f32x4 acc[2][2][4][2];
#pragma unroll
    for (int a = 0; a < 2; ++a)
#pragma unroll
        for (int b = 0; b < 2; ++b)
#pragma unroll
            for (int m = 0; m < 4; ++m)
#pragma unroll
                for (int n = 0; n < 2; ++n) acc[a][b][m][n] = (f32x4){0.f, 0.f, 0.f, 0.f};
    bf16x8 At[4][2], B0[2][2], B1[2][2];
    const char* cA = (const char*)g.A + (size_t)cur.pm * tstep; const char* cB = (const char*)g.Bt + (size_t)cur.pn * tstep;
    S.a_ready(cur);
    if constexpr (SP2) {
        PG8_STAGE(PG8_SB(0, 0), cB, voffB); PG8_STAGE(PG8_SB(0, 1), cB + hstep, voffB); PG8_STAGE(PG8_SA(0, 0), cA, voffA); PG8_STAGE(PG8_SA(0, 1), cA + hstep, voffA);
        if (wr == 1) PG8_BAR;
        PG8_WAIT_V(2); PG8_BAR;
        PG8_STAGE(PG8_SB(1, 0), cB + kstep, voffB); PG8_STAGE(PG8_SA(1, 0), cA + kstep, voffA); PG8_STAGE(PG8_SB(1, 1), cB + hstep + kstep, voffB);
        PG8_WAIT_V(6); PG8_BAR;
    } else {
        PG8_STAGE(PG8_SB(0, 0), cB, voffB); PG8_STAGE(PG8_SA(0, 0), cA, voffA); PG8_STAGE(PG8_SB(0, 1), cB + hstep, voffB); PG8_STAGE(PG8_SA(0, 1), cA + hstep, voffA);
        if (wr == 1) PG8_BAR;
        PG8_WAIT_V(4); PG8_BAR;
        PG8_STAGE(PG8_SB(1, 0), cB + kstep, voffB); PG8_STAGE(PG8_SA(1, 0), cA + kstep, voffA); PG8_STAGE(PG8_SB(1, 1), cB + hstep + kstep, voffB);
        PG8_WAIT_V(6); PG8_BAR;
    }
    for (;;) {
        const bool has_next = S.next(ui + 1, nxt);
        const char* nA = has_next ? (const char*)g.A + (size_t)nxt.pm * tstep : cA; const char* nB = has_next ? (const char*)g.Bt + (size_t)nxt.pn * tstep : cB;
        for (int t = 0; t < nt; t += 2) {
            const bool last = (t == nt - 2);
            const char* a1 = cA + (size_t)(t + 1) * kstep;
            const char* a2 = last ? nA : cA + (size_t)(t + 2) * kstep; const char* b2 = last ? nB : cB + (size_t)(t + 2) * kstep;
            const char* a3 = a2 + kstep; const char* b3 = b2 + kstep;
            if (last && has_next) S.a_ready(nxt);
            if constexpr (SP2) {
            PG8_LDB(B0, 0, 0); PG8_LDB(B1, 0, 1); PG8_SCHED; PG8_LDA(At, 0, 0); PG8_STAGE(PG8_SA(1, 1), a1 + hstep, voffA);
            PG8_WAIT_V(8); PG8_WAIT_L(0); PG8_BAR; PG8_MMA(0, 0, At, B0); PG8_MMA(0, 1, At, B1); PG8_BAR; PG8_SCHED;
            PG8_LDA(At, 0, 1); PG8_STAGE(PG8_SB(0, 0), b2, voffB); PG8_STAGE(PG8_SB(0, 1), b2 + hstep, voffB); PG8_STAGE(PG8_SA(0, 0), a2, voffA);
            PG8_WAIT_V(8); PG8_WAIT_L(0); PG8_BAR; PG8_MMA(1, 0, At, B0); PG8_MMA(1, 1, At, B1); PG8_BAR; PG8_SCHED;
            PG8_LDB(B0, 1, 0); PG8_LDB(B1, 1, 1); PG8_SCHED; PG8_LDA(At, 1, 0); PG8_STAGE(PG8_SA(0, 1), a2 + hstep, voffA);
            PG8_WAIT_V(8); PG8_WAIT_L(0); PG8_BAR; PG8_MMA(0, 0, At, B0); PG8_MMA(0, 1, At, B1); PG8_BAR; PG8_SCHED;
            PG8_LDA(At, 1, 1); PG8_STAGE(PG8_SB(1, 0), b3, voffB); PG8_STAGE(PG8_SB(1, 1), b3 + hstep, voffB); PG8_STAGE(PG8_SA(1, 0), a3, voffA);
            PG8_WAIT_V(8); PG8_WAIT_L(0); PG8_BAR; PG8_MMA(1, 0, At, B0); PG8_MMA(1, 1, At, B1); PG8_BAR; PG8_SCHED;
            } else {
            PG8_LDB(B0, 0, 0); PG8_SCHED; PG8_LDA(At, 0, 0); PG8_STAGE(PG8_SA(1, 1), a1 + hstep, voffA);
            PG8_WAIT_L(8); PG8_BAR; PG8_WAIT_L(0); PG8_MMA(0, 0, At, B0); PG8_BAR; PG8_SCHED;
            PG8_LDB(B1, 0, 1); PG8_STAGE(PG8_SB(0, 0), b2, voffB);
            PG8_BAR; PG8_WAIT_L(0); PG8_MMA(0, 1, At, B1); PG8_BAR;
            PG8_LDA(At, 0, 1); PG8_STAGE(PG8_SA(0, 0), a2, voffA);
            PG8_BAR; PG8_WAIT_L(0); PG8_MMA(1, 0, At, B0); PG8_BAR; PG8_SCHED;
            PG8_STAGE(PG8_SB(0, 1), b2 + hstep, voffB);
            PG8_WAIT_V(6); PG8_BAR; PG8_MMA(1, 1, At, B1); PG8_BAR;
            PG8_LDB(B0, 1, 0); PG8_SCHED; PG8_LDA(At, 1, 0); PG8_STAGE(PG8_SA(0, 1), a2 + hstep, voffA);
            PG8_WAIT_L(8); PG8_BAR; PG8_WAIT_L(0); PG8_MMA(0, 0, At, B0); PG8_BAR; PG8_SCHED;
            PG8_LDB(B1, 1, 1); PG8_STAGE(PG8_SB(1, 0), b3, voffB);
            PG8_BAR; PG8_WAIT_L(0); PG8_MMA(0, 1, At, B1); PG8_BAR;
            PG8_LDA(At, 1, 1); PG8_STAGE(PG8_SA(1, 0), a3, voffA);
            PG8_BAR; PG8_WAIT_L(0); PG8_MMA(1, 0, At, B0); PG8_BAR; PG8_SCHED;
            PG8_STAGE(PG8_SB(1, 1), b3 + hstep, voffB);
            PG8_WAIT_V(6); PG8_BAR; PG8_MMA(1, 1, At, B1); PG8_BAR;
            }
        }
        if constexpr (ALIGN_EPI) { if (wr == 0) PG8_BAR; }
        if constexpr (!Epi::AFTER_DRAIN) { E(acc, cur, wr, wc, fr, fq); S.done(cur); }
        if (!has_next) break;
#pragma unroll
        for (int a = 0; a < 2; ++a)
#pragma unroll
            for (int b = 0; b < 2; ++b)
#pragma unroll
                for (int m = 0; m < 4; ++m)
#pragma unroll
                    for (int n = 0; n < 2; ++n) acc[a][b][m][n] = (f32x4){0.f, 0.f, 0.f, 0.f};
        cur = nxt; cA = nA; cB = nB; ++ui;
        if constexpr (ALIGN_EPI) { if (wr == 1) PG8_BAR; }
    }
    PG8_WAIT_V(0);
    if constexpr (!ALIGN_EPI) { if (wr == 0) PG8_BAR; }
    PG8_BAR;
    if constexpr (Epi::AFTER_DRAIN) { E.fused(acc, cur, wr, wc, fr, fq, lds, wid, lane); S.done(cur); }
#undef PG8_SA
#undef PG8_SB
#undef PG8_STAGE
#undef PG8_LDA
#undef PG8_LDB
#undef PG8_MMA
#undef PG8_WAIT_V
#undef PG8_WAIT_L
#undef PG8_BAR
#undef PG8_SCHED
}
}
#define GAS __attribute__((address_space(1)))
#define LAS __attribute__((address_space(3)))
typedef unsigned short bf16;
typedef unsigned v4u __attribute__((ext_vector_type(4)));
typedef float f32x4 __attribute__((ext_vector_type(4)));
typedef short bf16x8 __attribute__((ext_vector_type(8)));
typedef GAS unsigned gu32;
typedef GAS unsigned long long gu64;
#define RLX_AGENT __ATOMIC_RELAXED, __HIP_MEMORY_SCOPE_AGENT
#define LDS_WAIT() asm volatile("s_waitcnt lgkmcnt(0)" ::: "memory")
#define VM_WAIT() asm volatile("s_waitcnt vmcnt(0)" ::: "memory")
__device__ __forceinline__ unsigned long long rt() { return __builtin_amdgcn_s_memrealtime(); }
__device__ __forceinline__ unsigned f2bf(float f) { unsigned u = __builtin_bit_cast(unsigned, f); return (u + 0x7fffu + ((u >> 16) & 1u)) >> 16; }
__device__ __forceinline__ unsigned pk2(float lo, float hi) { return f2bf(lo) | (f2bf(hi) << 16); }

#define XB_TMO      128
#define XB_XCNT(j)  (256  + 64 * (j))
#define XB_XSUB(j)  (1280 + 64 * (j))
#define XB_XGEN(j)  (2304 + 64 * (j))
#define XB_TOP      3328
#define XB_TOPGEN   3392
#define XCD_BAR_WORDS 3456
#define XB_SPIN_CAP (1u << 18)

__device__ __forceinline__ unsigned xb_ld(unsigned* p)              { return __hip_atomic_load(p, __ATOMIC_RELAXED, __HIP_MEMORY_SCOPE_AGENT); }
__device__ __forceinline__ unsigned xb_add(unsigned* p, unsigned v) { return __hip_atomic_fetch_add(p, v, __ATOMIC_RELAXED, __HIP_MEMORY_SCOPE_AGENT); }
__device__ __forceinline__ unsigned xb_xcc_id() { return (unsigned)__builtin_amdgcn_s_getreg((3 << 11) | 20) & 0xFu; }
#define XB_SPIN(cond, bar) do { unsigned _sp = 0; while (cond) { __builtin_amdgcn_s_sleep(1); \
    if ((++_sp & 255u) == 0u) { if (xb_ld(&(bar)[XB_TMO])) break; if (_sp > XB_SPIN_CAP) { atomicAdd(&(bar)[XB_TMO], 1u); break; } } } } while (0)

struct XcdBarrier {
    unsigned* bar; unsigned x;
    volatile LAS unsigned* st;
};

__device__ __forceinline__ XcdBarrier xcd_barrier_post(unsigned* bar, volatile LAS unsigned* st) {
    XcdBarrier b; b.bar = bar; b.x = xb_xcc_id(); b.st = st;
    if (threadIdx.x == 0) (void)xb_add(&bar[XB_XCNT(b.x)], 1u);
    return b;
}
__device__ __forceinline__ void xcd_barrier_complete(unsigned* bar, unsigned x, unsigned& nloc, unsigned& nx) {
    const unsigned G = gridDim.x * gridDim.y * gridDim.z;
    unsigned sum, cnt, mine, sp = 0u;
    for (;;) {
        sum = 0u; cnt = 0u; mine = 0u;
#pragma unroll
        for (unsigned j = 0; j < 16; ++j) { const unsigned c = xb_ld(&bar[XB_XCNT(j)]); sum += c; cnt += (c > 0u) ? 1u : 0u; mine = (j == x) ? c : mine; }
        if (sum == G) break;
        __builtin_amdgcn_s_sleep(1);
        if ((++sp & 255u) == 0u) { if (xb_ld(&bar[XB_TMO])) break; if (sp > XB_SPIN_CAP) { atomicAdd(&bar[XB_TMO], 1u); break; } }
    }
    nloc = mine > 0u ? mine : 1u; nx = cnt > 0u ? cnt : 1u;
}

__device__ __forceinline__ void xcd_barrier(const XcdBarrier& b) {
    asm volatile("s_waitcnt vmcnt(0)" ::: "memory");
    __syncthreads();
    if (threadIdx.x == 0) {
        unsigned* bar = b.bar;
        __builtin_amdgcn_s_waitcnt(0);
        unsigned nloc = b.st[0], nx = b.st[1];
        if (nloc == 0u) { xcd_barrier_complete(bar, b.x, nloc, nx); b.st[0] = nloc; b.st[1] = nx; }
        const unsigned old = xb_add(&bar[XB_XSUB(b.x)], 1u);
        const unsigned gen = old / nloc;
        if (old + 1u == (gen + 1u) * nloc) {
            __builtin_amdgcn_fence(__ATOMIC_RELEASE, "agent");
            asm volatile("s_waitcnt vmcnt(0)" ::: "memory");
            const unsigned og = xb_add(&bar[XB_TOP], 1u);
            const unsigned tg = og / nx;
            if (og + 1u == (tg + 1u) * nx) xb_add(&bar[XB_TOPGEN], 1u);
            else XB_SPIN(xb_ld(&bar[XB_TOPGEN]) == tg, bar);
            __builtin_amdgcn_fence(__ATOMIC_ACQUIRE, "agent");
            xb_add(&bar[XB_XGEN(b.x)], 1u);
            asm volatile("s_waitcnt vmcnt(0)" ::: "memory");
        } else {
            XB_SPIN(xb_ld(&bar[XB_XGEN(b.x)]) == gen, bar);
            __builtin_amdgcn_fence(__ATOMIC_ACQUIRE, "agent");
            asm volatile("s_waitcnt vmcnt(0)" ::: "memory");
        }
    }
    __syncthreads();
}
constexpr int NWAVES = 8;
constexpr int DM = 2048, DFF = 5632, SBW = 1024, RWW = 1024, RWC = 3520, RWCP = 3584;
constexpr int TP = 8192, NBP = 2, TS = 64, NBS = 32, PAST = 4096;
constexpr int MPROMPT = NBP * TP, MSAMPLE = NBS * TS, M = MPROMPT + MSAMPLE;
constexpr int NGU = 2 * DFF;
constexpr int NWIN = 42 * 256;
constexpr int KLORA = 512, NLORA = 3072;
constexpr int CH = 64, NCH = TP / CH;
static_assert(M % 256 == 0 && MPROMPT % 256 == 0 && pg8::MP == MPROMPT, "row panels");
constexpr size_t O_Y = 0, O_KP = (size_t)M * DM, O_VP = O_KP + (size_t)MPROMPT * SBW, O_WKVP = O_VP + (size_t)MPROMPT * SBW, O_SHP = O_WKVP + (size_t)NBP * 16 * 4096,
                 O_KS = O_SHP + (size_t)NBP * RWC, O_VS = O_KS + (size_t)MSAMPLE * SBW, O_WKVS = O_VS + (size_t)MSAMPLE * SBW, O_SHS = O_WKVS + (size_t)NBS * 16 * 4096, O_END = O_SHS + (size_t)NBS * RWC;
static_assert(O_END == 77845376, "output size");
constexpr size_t MiB = 1u << 20;
constexpr size_t al256(size_t x) { return (x + 255) & ~(size_t)255; }
constexpr size_t WS_CTL = 0, CTL_ZERO_BYTES = 1 * MiB;
constexpr size_t WS_W1GU = 1 * MiB;
constexpr size_t WS_W1D  = WS_W1GU + (size_t)NGU * DM * 2;
constexpr size_t WS_W2GU = WS_W1D + (size_t)DM * DFF * 2;
constexpr size_t WS_W2D  = WS_W2GU + (size_t)NGU * DM * 2;
constexpr size_t WS_WIN  = WS_W2D + (size_t)DM * DFF * 2;
constexpr size_t WS_WSBO = WS_WIN + (size_t)NWIN * DM * 2;
constexpr size_t WS_WRWO = WS_WSBO + (size_t)DM * SBW * 2;
constexpr size_t WS_WOUT = WS_WRWO + (size_t)DM * RWW * 2;
constexpr size_t WS_WLORA = WS_WOUT + (size_t)DM * DM * 2;
constexpr size_t WS_XN   = al256(WS_WLORA + (size_t)NLORA * KLORA * 2);
constexpr size_t WS_H    = WS_XN + (size_t)M * DM * 2;
constexpr size_t WS_HRES = WS_H + (size_t)M * DFF * 2;
constexpr size_t WS_QB   = WS_HRES + (size_t)M * DM * 4;
constexpr size_t WS_PRW  = WS_QB + (size_t)M * SBW * 2;
constexpr size_t WS_GSB  = WS_PRW + (size_t)M * RWCP * 2;
constexpr size_t WS_GRW  = WS_GSB + (size_t)M * DM * 2;
constexpr size_t WS_AO   = WS_GRW + (size_t)M * DM * 2;
constexpr size_t WS_XR   = WS_AO + (size_t)M * SBW * 2;
constexpr size_t WS_XK   = WS_XR + (size_t)M * RWW * 2;
constexpr size_t WS_XV   = WS_XK + (size_t)M * RWW * 2;
constexpr size_t WS_ACAT = WS_XV + (size_t)M * RWW * 2;
constexpr size_t WS_WD   = WS_ACAT + (size_t)M * KLORA * 2;
constexpr size_t WS_KP   = WS_WD + (size_t)M * RWW * 4;
constexpr size_t WS_KKN  = WS_KP + (size_t)M * RWW * 2;
constexpr size_t WS_BV   = WS_KKN + (size_t)M * RWW * 2;
constexpr size_t WS_G    = WS_BV + (size_t)M * RWW * 2;
constexpr size_t WS_YRW  = WS_G + (size_t)M * RWW * 2;
constexpr size_t WS_PC   = WS_YRW + (size_t)M * RWW * 2;
constexpr size_t WS_UC   = WS_PC + (size_t)32 * NCH * 4096 * 4;
constexpr size_t WS_SC   = WS_UC + (size_t)32 * NCH * 4096 * 4;
constexpr size_t WS_END  = WS_SC + (size_t)32 * NCH * 4096 * 4;
static_assert((size_t)M * DM * 4 <= (size_t)M * DFF * 2, "MPART fits in H");
constexpr int CW_BAR = 4096;
constexpr int RING_OFF = 0, RING_BYTES = 131072;
constexpr int LDSCTL_OFF = RING_BYTES, MISC_OFF = LDSCTL_OFF + 320;
constexpr int LDS_BYTES = 147456;
static_assert(MISC_OFF + 128 <= LDS_BYTES && pg8::STAGE_BYTES <= RING_BYTES, "LDS map");

struct Params {
    const float* in[32]; float* out; unsigned char* ws; int ph_lo, ph_hi;
};
typedef float f32x16 __attribute__((ext_vector_type(16)));
typedef unsigned u32x2 __attribute__((ext_vector_type(2)));
__device__ __forceinline__ unsigned cvtpk(float lo, float hi) { return pg8::cvt_pk_bf16(lo, hi); }
__device__ __forceinline__ float bf_lo(unsigned w) { return __uint_as_float(w << 16); }
__device__ __forceinline__ float bf_hi(unsigned w) { return __uint_as_float(w & 0xffff0000u); }
__device__ __forceinline__ float wave_sum(float v) {
#pragma unroll
    for (int o = 1; o < 64; o <<= 1) v += __shfl_xor(v, o);
    return v;
}
template <int CTRL> __device__ __forceinline__ float dppf(float x) { return __builtin_bit_cast(float, __builtin_amdgcn_update_dpp(0, __builtin_bit_cast(int, x), CTRL, 0xf, 0xf, true)); }
__device__ __forceinline__ float red8(float x) {
    x += dppf<0xB1>(x);
    x += dppf<0x4E>(x);
    x += dppf<0x141>(x);
    return x;
}
__device__ __forceinline__ float red_hi8(float x) {
    x += dppf<0x128>(x);
    x += __shfl_xor(x, 16); x += __shfl_xor(x, 32);
    return x;
}

__device__ __forceinline__ void p0_transpose_item(const float* W, int K, int N, bf16* WT, int vrow0, int k0, int n0, LAS float* scr, int lane) {
#pragma unroll 8
    for (int i = 0; i < 32; ++i) { const int kk = 2 * i + (lane >> 5); scr[kk * 33 + (lane & 31)] = W[(size_t)(k0 + kk) * N + n0 + (lane & 31)]; }
    LDS_WAIT(); asm volatile("" ::: "memory");
    const int c = lane & 7;
#pragma unroll
    for (int j = 0; j < 4; ++j) { const int n = (lane >> 3) + 8 * j; const LAS float* s = scr + (8 * c) * 33 + n;
        v4u o; o.x = cvtpk(s[0 * 33], s[1 * 33]); o.y = cvtpk(s[2 * 33], s[3 * 33]); o.z = cvtpk(s[4 * 33], s[5 * 33]); o.w = cvtpk(s[6 * 33], s[7 * 33]);
        *(v4u*)(WT + (size_t)(vrow0 + n) * K + k0 + 8 * c) = o; }
    LDS_WAIT(); asm volatile("" ::: "memory");
}
__device__ __forceinline__ int headperm_v(int w) { return 128 * ((w & 63) >> 5) + 32 * (w >> 6) + (w & 31); }
__device__ __forceinline__ int win_vrow(int n) {
    if (n < 2048) return (n & ~255) + headperm_v(n & 255);
    if (n < 6592) return n;
    return n + 64;
}
__device__ __forceinline__ void rms_row_to_bf16(const float* xrow, const float* gain, bf16* orow, int lane) {
    const f32x4* xr = (const f32x4*)xrow + lane; f32x4 v[8]; float s = 0.f;
#pragma unroll
    for (int j = 0; j < 8; ++j) { v[j] = xr[64 * j]; s += (v[j].x * v[j].x + v[j].y * v[j].y) + (v[j].z * v[j].z + v[j].w * v[j].w); }
    const float rs = 1.0f / sqrtf(wave_sum(s) * (1.0f / DM) + 1e-6f);
    u32x2* o8 = (u32x2*)orow + lane;
#pragma unroll
    for (int j = 0; j < 8; ++j) { const f32x4 g = *((const f32x4*)gain + lane + 64 * j); u32x2 w; w.x = cvtpk(v[j].x * rs * g.x, v[j].y * rs * g.y); w.y = cvtpk(v[j].z * rs * g.z, v[j].w * rs * g.w); o8[64 * j] = w; }
}
__device__ __forceinline__ void p0_prologue(const Params& p, LAS unsigned char* lds, int gw, int NGW, int wave, int lane) {
    LAS float* scr = (LAS float*)(lds + RING_OFF + wave * 16384);
    unsigned char* ws = p.ws;
    constexpr int I_G = (DM / 64) * (DFF / 32), I_D = (DFF / 64) * (DM / 32), I_IN = (DM / 64) * (10688 / 32), I_O = (SBW / 64) * (DM / 32), I_OUT = (DM / 64) * (DM / 32);
    constexpr int NITEMS = 4 * I_G + 2 * I_D + I_IN + 2 * I_O + I_OUT;
    for (int it = gw; it < NITEMS; it += NGW) {
        int r = it;
        if (r < 4 * I_G) { const int which = r / I_G; r -= which * I_G; const int ffn = which >> 1, up = which & 1;
            const float* W = p.in[(ffn ? 29 : 7) + up]; bf16* WT = (bf16*)(ws + (ffn ? WS_W2GU : WS_W1GU));
            const int nblk = DFF / 32, kb = r / nblk, nb = r % nblk, n0 = 32 * nb; const int vrow0 = 256 * (n0 >> 7) + (n0 & 127) + 128 * up;
            p0_transpose_item(W, DM, DFF, WT, vrow0, 64 * kb, n0, scr, lane); continue; }
        r -= 4 * I_G;
        if (r < 2 * I_D) { const int ffn = r / I_D; r -= ffn * I_D; const float* W = p.in[ffn ? 31 : 9]; bf16* WT = (bf16*)(ws + (ffn ? WS_W2D : WS_W1D));
            const int nblk = DM / 32, kb = r / nblk, nb = r % nblk; p0_transpose_item(W, DFF, DM, WT, 32 * nb, 64 * kb, 32 * nb, scr, lane); continue; }
        r -= 2 * I_D;
        if (r < I_IN) { const int nblk = 10688 / 32, kb = r / nblk, nb = r % nblk, n0 = 32 * nb; p0_transpose_item(p.in[11], DM, 10688, (bf16*)(ws + WS_WIN), win_vrow(n0), 64 * kb, n0, scr, lane); continue; }
        r -= I_IN;
        if (r < 2 * I_O) { const int which = r / I_O; r -= which * I_O; const int nblk = DM / 32, kb = r / nblk, nb = r % nblk;
            p0_transpose_item(p.in[which ? 26 : 14], SBW, DM, (bf16*)(ws + (which ? WS_WRWO : WS_WSBO)), 32 * nb, 64 * kb, 32 * nb, scr, lane); continue; }
        r -= 2 * I_O;
        { const int nblk = DM / 32, kb = r / nblk, nb = r % nblk; p0_transpose_item(p.in[27], DM, DM, (bf16*)(ws + WS_WOUT), 32 * nb, 64 * kb, 32 * nb, scr, lane); }
    }
    { const int gt = gw * 64 + lane, NGT = NGW * 64; bf16* WT = (bf16*)(ws + WS_WIN) + (size_t)6592 * DM;
        for (int c = gt; c < 64 * DM / 8; c += NGT) *(v4u*)(WT + (size_t)c * 8) = (v4u){0u, 0u, 0u, 0u};
        bf16* WL = (bf16*)(ws + WS_WLORA);
        for (int c = gt; c < NLORA * (KLORA / 8); c += NGT) { const int vrow = c >> 6, kc = (c & 63) * 8; const int type = vrow >> 10, v = vrow & 255, tile = (vrow >> 8) & 3;
            const int ncol = tile * 256 + 64 * ((v >> 5) & 3) + 32 * (v >> 7) + (v & 31);
            const float* W = p.in[type == 0 ? 17 : (type == 1 ? 19 : 20)]; const int koff = type == 0 ? 0 : (type == 1 ? 128 : 256), kn = type == 2 ? 256 : 96;
            float f[8];
#pragma unroll
            for (int e = 0; e < 8; ++e) { const int k = kc + e - koff; f[e] = (k >= 0 && k < kn) ? W[(size_t)k * 1024 + ncol] : 0.f; }
            *(v4u*)(WL + (size_t)vrow * KLORA + kc) = (v4u){cvtpk(f[0], f[1]), cvtpk(f[2], f[3]), cvtpk(f[4], f[5]), cvtpk(f[6], f[7])}; } }
    for (int m = gw; m < M; m += NGW) { const float* xr = m < MPROMPT ? p.in[0] + (size_t)m * DM : p.in[1] + (size_t)(m - MPROMPT) * DM; rms_row_to_bf16(xr, p.in[6], (bf16*)(ws + WS_XN) + (size_t)m * DM, lane); }
}
__device__ __forceinline__ void norm_phase(const float* H, const float* gain, bf16* XN, int gw, int NGW, int lane) {
    for (int m = gw; m < M; m += NGW) rms_row_to_bf16(H + (size_t)m * DM, gain, XN + (size_t)m * DM, lane);
}
constexpr int VT_PITCH = 36;
constexpr int VT_BYTES = 64 * VT_PITCH * 2;
constexpr int N_ATT_UNITS = NBP * 16 * (TP / 32) + NBS * 16 * (TS / 32);
__device__ __forceinline__ int crow(int r, int hi) { return (r & 3) + 8 * (r >> 2) + 4 * hi; }
__device__ __forceinline__ void attn_unit(const Params& p, int unit, LAS unsigned char* vtb, int lane, const bf16x8 (&mtri)[2]) {
    const int r32 = lane & 31, hi = lane >> 5;
    int h, qb, P; size_t row0; const float *kn, *vn, *kc = nullptr, *vc = nullptr;
    if (unit < NBP * 16 * (TP / 32)) { const int b = unit >> 12; h = (unit >> 8) & 15; qb = unit & 255; P = 0; row0 = (size_t)b * TP; kn = p.out + O_KP + row0 * SBW; vn = p.out + O_VP + row0 * SBW; }
    else { const int u2 = unit - NBP * 16 * (TP / 32); const int s = u2 >> 5; h = (u2 >> 1) & 15; qb = u2 & 1; P = PAST; row0 = (size_t)MPROMPT + (size_t)s * TS;
        kn = p.out + O_KS + (size_t)s * TS * SBW; vn = p.out + O_VS + (size_t)s * TS * SBW; kc = p.in[2] + (size_t)s * PAST * SBW; vc = p.in[3] + (size_t)s * PAST * SBW; }
    const bf16* Qb = (const bf16*)(p.ws + WS_QB) + (row0 + (size_t)qb * 32 + r32) * SBW + h * 64 + hi * 8;
    bf16x8 qf[4];
#pragma unroll
    for (int d0 = 0; d0 < 4; ++d0) qf[d0] = *(const bf16x8*)(Qb + 16 * d0);
    f32x16 o0 = {}, o1 = {}; float carry = 0.f;
    LAS unsigned short* vt = (LAS unsigned short*)vtb;
    const int nq = P + qb * 32;
    for (int n0 = nq; n0 >= 0; n0 -= 32) {
        const float* kb = (n0 >= P ? kn + (size_t)(n0 - P) * SBW : kc + (size_t)n0 * SBW) + h * 64;
        const float* vb = (n0 >= P ? vn + (size_t)(n0 - P) * SBW : vc + (size_t)n0 * SBW) + h * 64;
        f32x4 vr[8];
#pragma unroll
        for (int i = 0; i < 8; ++i) vr[i] = *(const f32x4*)(vb + (size_t)((lane >> 4) + 4 * i) * SBW + 4 * (lane & 15));
        f32x16 s = {};
#pragma unroll
        for (int d0 = 0; d0 < 4; ++d0) { const float* kp = kb + (size_t)r32 * SBW + 16 * d0 + 8 * hi; const f32x4 a = *(const f32x4*)kp, b = *(const f32x4*)(kp + 4);
            const v4u w = (v4u){cvtpk(a[0], a[1]), cvtpk(a[2], a[3]), cvtpk(b[0], b[1]), cvtpk(b[2], b[3])};
            s = __builtin_amdgcn_mfma_f32_32x32x16_bf16(__builtin_bit_cast(bf16x8, w), qf[d0], s, 0, 0, 0); }
#pragma unroll
        for (int i = 0; i < 8; ++i) { const int key = (lane >> 4) + 4 * i, d = 4 * (lane & 15); const unsigned w0 = cvtpk(vr[i][0], vr[i][1]), w1 = cvtpk(vr[i][2], vr[i][3]);
            vt[(d + 0) * VT_PITCH + key] = (unsigned short)(w0 & 0xffffu); vt[(d + 1) * VT_PITCH + key] = (unsigned short)(w0 >> 16);
            vt[(d + 2) * VT_PITCH + key] = (unsigned short)(w1 & 0xffffu); vt[(d + 3) * VT_PITCH + key] = (unsigned short)(w1 >> 16); }
        asm volatile("" ::: "memory");
        const bool diag = (n0 == nq);
        float lk[16], lb[16]; float lsum = 0.f;
#pragma unroll
        for (int r = 0; r < 16; ++r) { const float z = s[r]; const float sp = fmaxf(z, 0.f) + __logf(1.0f + __expf(-fabsf(z)));
            const bool valid = !diag || (crow(r, hi) < r32);
            lk[r] = valid ? -sp : 0.f; lb[r] = valid ? (z - sp) : -INFINITY; lsum += lk[r]; }
        f32x16 tl = {};
#pragma unroll
        for (int kk = 0; kk < 2; ++kk) { v4u wh, wl;
#pragma unroll
            for (int e = 0; e < 4; ++e) { const float x0 = lk[8 * kk + 2 * e], x1 = lk[8 * kk + 2 * e + 1]; const unsigned w = cvtpk(x0, x1); wh[e] = w; wl[e] = cvtpk(x0 - bf_lo(w), x1 - bf_hi(w)); }
            tl = __builtin_amdgcn_mfma_f32_32x32x16_bf16(mtri[kk], __builtin_bit_cast(bf16x8, wh), tl, 0, 0, 0);
            tl = __builtin_amdgcn_mfma_f32_32x32x16_bf16(mtri[kk], __builtin_bit_cast(bf16x8, wl), tl, 0, 0, 0); }
        v4u wk[2];
#pragma unroll
        for (int kk = 0; kk < 2; ++kk)
#pragma unroll
            for (int e = 0; e < 4; ++e) { const int r = 8 * kk + 2 * e; wk[kk][e] = cvtpk(__expf(lb[r] + carry + tl[r]), __expf(lb[r + 1] + carry + tl[r + 1])); }
#pragma unroll
        for (int kk = 0; kk < 2; ++kk) {
            const LAS unsigned short* a0p = vt + r32 * VT_PITCH + 16 * kk + 4 * hi; const LAS unsigned short* a1p = a0p + 32 * VT_PITCH;
            const u32x2 x0 = *(const LAS u32x2*)a0p, x1 = *(const LAS u32x2*)(a0p + 8), y0 = *(const LAS u32x2*)a1p, y1 = *(const LAS u32x2*)(a1p + 8);
            o0 = __builtin_amdgcn_mfma_f32_32x32x16_bf16(__builtin_bit_cast(bf16x8, (v4u){x0.x, x0.y, x1.x, x1.y}), __builtin_bit_cast(bf16x8, wk[kk]), o0, 0, 0, 0);
            o1 = __builtin_amdgcn_mfma_f32_32x32x16_bf16(__builtin_bit_cast(bf16x8, (v4u){y0.x, y0.y, y1.x, y1.y}), __builtin_bit_cast(bf16x8, wk[kk]), o1, 0, 0, 0); }
        asm volatile("" ::: "memory");
        lsum += __shfl_xor(lsum, 32); carry += lsum;
        if (__all(carry < -104.0f)) break;
    }
    bf16* O = (bf16*)(p.ws + WS_AO) + (row0 + (size_t)qb * 32 + r32) * SBW + h * 64 + 4 * hi;
#pragma unroll
    for (int g = 0; g < 4; ++g) { u32x2 a, b; a.x = cvtpk(o0[4 * g], o0[4 * g + 1]); a.y = cvtpk(o0[4 * g + 2], o0[4 * g + 3]); b.x = cvtpk(o1[4 * g], o1[4 * g + 1]); b.y = cvtpk(o1[4 * g + 2], o1[4 * g + 3]);
        *(u32x2*)(O + 8 * g) = a; *(u32x2*)(O + 32 + 8 * g) = b; }
}
__device__ __forceinline__ void attn_phase(const Params& p, LAS unsigned char* lds, int gw, int NGW, int wave, int lane) {
    bf16x8 mtri[2]; const int r32 = lane & 31, hi = lane >> 5;
#pragma unroll
    for (int kk = 0; kk < 2; ++kk)
#pragma unroll
        for (int e = 0; e < 8; ++e) mtri[kk][e] = (crow(8 * kk + e, hi) > r32) ? (short)0x3F80 : (short)0;
    for (int u = gw; u < N_ATT_UNITS; u += NGW) attn_unit(p, u, lds + RING_OFF + wave * VT_BYTES, lane, mtri);
}
__device__ __forceinline__ void shift_phase(const Params& p, int gw, int NGW, int lane) {
    const bf16* PRW = (const bf16*)(p.ws + WS_PRW); const float* mu = p.in[15];
    bf16* XR = (bf16*)(p.ws + WS_XR); bf16* ACAT = (bf16*)(p.ws + WS_ACAT);
    for (int m = gw; m < M; m += NGW) {
        const bool prompt = m < MPROMPT; const int t = prompt ? (m & (TP - 1)) : ((m - MPROMPT) & (TS - 1)); const bool first = (t == 0);
        const float* sh0 = prompt ? nullptr : p.in[5] + (size_t)((m - MPROMPT) >> 6) * RWC;
#pragma unroll 1
        for (int it = 0; it < 7; ++it) { const int ch = lane + 64 * it; if (ch >= RWC / 8) break; const int col = ch * 8;
            const v4u pw = *(const v4u*)(PRW + (size_t)m * RWCP + col); float pv[8], qv[8];
            pv[0] = bf_lo(pw.x); pv[1] = bf_hi(pw.x); pv[2] = bf_lo(pw.y); pv[3] = bf_hi(pw.y); pv[4] = bf_lo(pw.z); pv[5] = bf_hi(pw.z); pv[6] = bf_lo(pw.w); pv[7] = bf_hi(pw.w);
            if (!first) { const v4u qw = *(const v4u*)(PRW + (size_t)(m - 1) * RWCP + col);
                qv[0] = bf_lo(qw.x); qv[1] = bf_hi(qw.x); qv[2] = bf_lo(qw.y); qv[3] = bf_hi(qw.y); qv[4] = bf_lo(qw.z); qv[5] = bf_hi(qw.z); qv[6] = bf_lo(qw.w); qv[7] = bf_hi(qw.w); }
            else if (prompt) {
#pragma unroll
                for (int e = 0; e < 8; ++e) qv[e] = 0.f; }
            else { const f32x4 a = *(const f32x4*)(sh0 + col), b = *(const f32x4*)(sh0 + col + 4); qv[0] = a[0]; qv[1] = a[1]; qv[2] = a[2]; qv[3] = a[3]; qv[4] = b[0]; qv[5] = b[1]; qv[6] = b[2]; qv[7] = b[3]; }
            const f32x4 m0 = *(const f32x4*)(mu + col), m1 = *(const f32x4*)(mu + col + 4); float x[8];
#pragma unroll
            for (int e = 0; e < 8; ++e) x[e] = pv[e] + (qv[e] - pv[e]) * (e < 4 ? m0[e] : m1[e - 4]);
            bf16* dst;
            if (col < 3072) dst = XR + (size_t)(col >> 10) * ((WS_XK - WS_XR) / 2) + (size_t)m * RWW + (col & 1023);
            else if (col < 3168) { dst = ACAT + (size_t)m * KLORA + (col - 3072);
#pragma unroll
                for (int e = 0; e < 8; ++e) x[e] = tanhf(x[e]); }
            else if (col < 3264) dst = ACAT + (size_t)m * KLORA + 128 + (col - 3168);
            else { dst = ACAT + (size_t)m * KLORA + 256 + (col - 3264);
#pragma unroll
                for (int e = 0; e < 8; ++e) x[e] = pg8::sigm(x[e]); }
            *(v4u*)dst = (v4u){cvtpk(x[0], x[1]), cvtpk(x[2], x[3]), cvtpk(x[4], x[5]), cvtpk(x[6], x[7])};
        }
        if (lane < 8) *(v4u*)(ACAT + (size_t)m * KLORA + (lane < 4 ? 96 + 8 * lane : 224 + 8 * (lane - 4))) = (v4u){0u, 0u, 0u, 0u};
    }
}
struct ScanRaw { v4u kn, b, kp, v, r, g; f32x4 w0, w1; };
__device__ __forceinline__ void cvt8(const v4u q, float (&f)[8]) { f[0] = bf_lo(q.x); f[1] = bf_hi(q.x); f[2] = bf_lo(q.y); f[3] = bf_hi(q.y); f[4] = bf_lo(q.z); f[5] = bf_hi(q.z); f[6] = bf_lo(q.w); f[7] = bf_hi(q.w); }
template <bool WITH_Y> __device__ __forceinline__ ScanRaw scan_load(const unsigned char* ws, size_t m, int cj, int ci) {
    ScanRaw x; const size_t oj = m * RWW + cj, oi = m * RWW + ci;
    x.kn = *(const v4u*)((const bf16*)(ws + WS_KKN) + oj); x.b = *(const v4u*)((const bf16*)(ws + WS_BV) + oj); x.kp = *(const v4u*)((const bf16*)(ws + WS_KP) + oj);
    x.v = *(const v4u*)((const bf16*)(ws + WS_XV) + oi);
    const float* wp = (const float*)(ws + WS_WD) + oj; x.w0 = *(const f32x4*)wp; x.w1 = *(const f32x4*)(wp + 4);
    if (WITH_Y) { x.r = *(const v4u*)((const bf16*)(ws + WS_XR) + oj); x.g = *(const v4u*)((const bf16*)(ws + WS_G) + oi); }
    return x;
}
#define SCAN_DOT(X, KN, OUT) do { _Pragma("unroll") for (int a = 0; a < 8; ++a) { float s_ = 0.f; _Pragma("unroll") for (int c = 0; c < 8; ++c) s_ += X[a][c] * KN[c]; OUT[a] = red8(s_); } } while (0)

__device__ __forceinline__ void scan_pass_a(const Params& p, int unit, int lane) {
    const int bh = unit / NCH, c = unit % NCH, b = bh >> 4, h = bh & 15, li = lane >> 3, lj = lane & 7;
    const size_t m0 = (size_t)b * TP + (size_t)c * CH; const int cj = h * 64 + 8 * lj, ci = h * 64 + 8 * li;
    float U[8][8], Pm[8][8];
#pragma unroll
    for (int a = 0; a < 8; ++a)
#pragma unroll
        for (int cc = 0; cc < 8; ++cc) { U[a][cc] = 0.f; Pm[a][cc] = (8 * li + a == 8 * lj + cc) ? 1.f : 0.f; }
    ScanRaw raw = scan_load<false>(p.ws, m0, cj, ci);
#pragma unroll 1
    for (int t = 0; t < CH; ++t) {
        float kn[8], bb[8], kp[8], v[8], w[8];
        cvt8(raw.kn, kn); cvt8(raw.b, bb); cvt8(raw.kp, kp); cvt8(raw.v, v);
#pragma unroll
        for (int e = 0; e < 4; ++e) { w[e] = raw.w0[e]; w[4 + e] = raw.w1[e]; }
        if (t + 1 < CH) raw = scan_load<false>(p.ws, m0 + t + 1, cj, ci);
        float du[8], dp[8];
        SCAN_DOT(U, kn, du); SCAN_DOT(Pm, kn, dp);
#pragma unroll
        for (int a = 0; a < 8; ++a)
#pragma unroll
            for (int cc = 0; cc < 8; ++cc) { U[a][cc] = U[a][cc] * w[cc] + (v[a] * kp[cc] - du[a] * bb[cc]); Pm[a][cc] = Pm[a][cc] * w[cc] - dp[a] * bb[cc]; }
    }
    float* Uo = (float*)(p.ws + WS_UC) + (size_t)unit * 4096; float* Po = (float*)(p.ws + WS_PC) + (size_t)unit * 4096;
#pragma unroll
    for (int a = 0; a < 8; ++a) { float* up = Uo + (8 * li + a) * 64 + 8 * lj; *(f32x4*)up = (f32x4){U[a][0], U[a][1], U[a][2], U[a][3]}; *(f32x4*)(up + 4) = (f32x4){U[a][4], U[a][5], U[a][6], U[a][7]}; }
#pragma unroll
    for (int cc = 0; cc < 8; ++cc)
#pragma unroll
        for (int ah = 0; ah < 2; ++ah) { const int jb = li >> 1, kq = (2 * li + ah) & 3, jpb = lj >> 1, jpl = 8 * (lj & 1) + cc;
            *(f32x4*)(Po + (((jpb * 4 + jb) * 64 + kq * 16 + jpl) * 4)) = (f32x4){Pm[4 * ah][cc], Pm[4 * ah + 1][cc], Pm[4 * ah + 2][cc], Pm[4 * ah + 3][cc]}; }
}
__device__ __forceinline__ void scan_pass_c(const Params& p, size_t m0, int h, int nsteps, const float* S0, float* Sfin, int lane) {
    const int li = lane >> 3, lj = lane & 7; const int cj = h * 64 + 8 * lj, ci = h * 64 + 8 * li;
    float S[8][8];
#pragma unroll
    for (int a = 0; a < 8; ++a) { const float* sp = S0 + (8 * li + a) * 64 + 8 * lj; const f32x4 x0 = *(const f32x4*)sp, x1 = *(const f32x4*)(sp + 4);
#pragma unroll
        for (int e = 0; e < 4; ++e) { S[a][e] = x0[e]; S[a][4 + e] = x1[e]; } }
    float lnw[8], lnb[8], rk[8];
    { const f32x4 a0 = *(const f32x4*)(p.in[24] + ci), a1 = *(const f32x4*)(p.in[24] + ci + 4), b0 = *(const f32x4*)(p.in[25] + ci), b1 = *(const f32x4*)(p.in[25] + ci + 4), c0 = *(const f32x4*)(p.in[23] + cj), c1 = *(const f32x4*)(p.in[23] + cj + 4);
#pragma unroll
        for (int e = 0; e < 4; ++e) { lnw[e] = a0[e]; lnw[4 + e] = a1[e]; lnb[e] = b0[e]; lnb[4 + e] = b1[e]; rk[e] = c0[e]; rk[4 + e] = c1[e]; } }
    bf16* Y = (bf16*)(p.ws + WS_YRW);
    ScanRaw raw = scan_load<true>(p.ws, m0, cj, ci);
#pragma unroll 1
    for (int t = 0; t < nsteps; ++t) {
        float kn[8], bb[8], kp[8], v[8], w[8], r[8], g[8];
        cvt8(raw.kn, kn); cvt8(raw.b, bb); cvt8(raw.kp, kp); cvt8(raw.v, v); cvt8(raw.r, r); cvt8(raw.g, g);
#pragma unroll
        for (int e = 0; e < 4; ++e) { w[e] = raw.w0[e]; w[4 + e] = raw.w1[e]; }
        if (t + 1 < nsteps) raw = scan_load<true>(p.ws, m0 + t + 1, cj, ci);
        float ds[8], y[8];
        SCAN_DOT(S, kn, ds);
#pragma unroll
        for (int a = 0; a < 8; ++a)
#pragma unroll
            for (int cc = 0; cc < 8; ++cc) S[a][cc] = S[a][cc] * w[cc] + (v[a] * kp[cc] - ds[a] * bb[cc]);
        SCAN_DOT(S, r, y);
        float rkk = 0.f;
#pragma unroll
        for (int cc = 0; cc < 8; ++cc) rkk += r[cc] * kp[cc] * rk[cc];
        rkk = red8(rkk);
        float s1 = 0.f;
#pragma unroll
        for (int a = 0; a < 8; ++a) s1 += y[a];
        const float mean = red_hi8(s1) * (1.0f / 64.0f); float s2 = 0.f;
#pragma unroll
        for (int a = 0; a < 8; ++a) { y[a] -= mean; s2 += y[a] * y[a]; }
        const float rstd = 1.0f / sqrtf(red_hi8(s2) * (1.0f / 64.0f) + 64e-5f);
        float o[8];
#pragma unroll
        for (int a = 0; a < 8; ++a) o[a] = ((y[a] * rstd) * lnw[a] + lnb[a] + rkk * v[a]) * g[a];
        if (lj == 0) *(v4u*)(Y + (m0 + t) * RWW + ci) = (v4u){cvtpk(o[0], o[1]), cvtpk(o[2], o[3]), cvtpk(o[4], o[5]), cvtpk(o[6], o[7])};
    }
    if (Sfin) {
#pragma unroll
        for (int a = 0; a < 8; ++a) { float* sp = Sfin + (8 * li + a) * 64 + 8 * lj; *(f32x4*)sp = (f32x4){S[a][0], S[a][1], S[a][2], S[a][3]}; *(f32x4*)(sp + 4) = (f32x4){S[a][4], S[a][5], S[a][6], S[a][7]}; }
    }
}
__device__ __forceinline__ void scan_pass_b(const Params& p, int unit, int lane) {
    const int bh = unit >> 2, ib = unit & 3, i = lane & 15, q4 = lane >> 4;
    const float* Pc = (const float*)(p.ws + WS_PC) + (size_t)bh * NCH * 4096; const float* Uc = (const float*)(p.ws + WS_UC) + (size_t)bh * NCH * 4096; float* Sc = (float*)(p.ws + WS_SC) + (size_t)bh * NCH * 4096;
    const int roff = (16 * ib + i) * 64 + 4 * q4;
    f32x4 S[4];
#pragma unroll
    for (int jb = 0; jb < 4; ++jb) S[jb] = (f32x4){0.f, 0.f, 0.f, 0.f};
    f32x4 pa[4][4], un[4];
#pragma unroll
    for (int x = 0; x < 4; ++x) { un[x] = *(const f32x4*)(Uc + roff + 16 * x);
#pragma unroll
        for (int jb = 0; jb < 4; ++jb) pa[x][jb] = *(const f32x4*)(Pc + ((x * 4 + jb) * 64 + lane) * 4); }
#pragma unroll 1
    for (int c = 0; c < NCH; ++c) {
#pragma unroll
        for (int jb = 0; jb < 4; ++jb) *(f32x4*)(Sc + (size_t)c * 4096 + roff + 16 * jb) = S[jb];
        f32x4 pc[4][4], acc[4];
#pragma unroll
        for (int x = 0; x < 4; ++x) { acc[x] = un[x];
#pragma unroll
            for (int jb = 0; jb < 4; ++jb) pc[x][jb] = pa[x][jb]; }
        if (c + 1 < NCH) {
#pragma unroll
            for (int x = 0; x < 4; ++x) { un[x] = *(const f32x4*)(Uc + (size_t)(c + 1) * 4096 + roff + 16 * x);
#pragma unroll
                for (int jb = 0; jb < 4; ++jb) pa[x][jb] = *(const f32x4*)(Pc + (size_t)(c + 1) * 4096 + ((x * 4 + jb) * 64 + lane) * 4); } }
#pragma unroll
        for (int x = 0; x < 4; ++x)
#pragma unroll
            for (int jb = 0; jb < 4; ++jb)
#pragma unroll
                for (int e = 0; e < 4; ++e) acc[x] = __builtin_amdgcn_mfma_f32_16x16x4f32(pc[x][jb][e], S[jb][e], acc[x], 0, 0, 0);
#pragma unroll
        for (int x = 0; x < 4; ++x) S[x] = acc[x];
    }
    float* Sf = p.out + O_WKVP + (size_t)bh * 4096;
#pragma unroll
    for (int jb = 0; jb < 4; ++jb) *(f32x4*)(Sf + roff + 16 * jb) = S[jb];
}
constexpr int N_PHASES = 15;
#ifndef MK_SPLIT
#define MK_SPLIT 1
#endif
__global__ void __launch_bounds__(NWAVES * 64, 2) fwd_kernel(Params p) {
    extern __shared__ __attribute__((aligned(16))) unsigned char lds_raw[];
    LAS unsigned char* lds = (LAS unsigned char*)lds_raw;
    volatile LAS unsigned* MISC = (volatile LAS unsigned*)(lds + MISC_OFF);
    const int tid = threadIdx.x, lane = tid & 63, wave = __builtin_amdgcn_readfirstlane(tid >> 6);
    const int G = gridDim.x, gw = blockIdx.x * NWAVES + wave, NGW = G * NWAVES;
    unsigned char* ws = p.ws;
    for (int u = tid; u < (LDS_BYTES - LDSCTL_OFF) / 4; u += NWAVES * 64) ((LAS unsigned*)(lds + LDSCTL_OFF))[u] = 0u;
    __syncthreads();
    XcdBarrier bar; bar.bar = (unsigned*)(ws + WS_CTL) + CW_BAR; bar.x = 0; bar.st = nullptr;
    if (!MK_SPLIT) bar = xcd_barrier_post((unsigned*)(ws + WS_CTL) + CW_BAR, MISC + 8);
    const int lo = p.ph_lo, hi = p.ph_hi;
#define IN(k) (lo <= (k) && (k) < hi)
#define SEAM(k) do { if (IN(k) && IN((k) + 1)) xcd_barrier(bar); } while (0)
    using pg8::Gemm; using pg8::StaticOrder;
    bf16* XN = (bf16*)(ws + WS_XN); bf16* HB = (bf16*)(ws + WS_H); float* HRES = (float*)(ws + WS_HRES);

    if (IN(0)) { p0_prologue(p, lds, gw, NGW, wave, lane); }
    SEAM(0);
    if (IN(1)) { Gemm g{XN, (const bf16*)(ws + WS_W1GU), M, NGU, DM}; StaticOrder S; S.init(M, NGU, G, (int)blockIdx.x); pg8::EpiGateUp E{HB, DFF};
        pg8::gemm_phase<pg8::EpiGateUp, StaticOrder, true, true>(lds + RING_OFF, g, S, E); }
    SEAM(1);
    if (IN(2)) { Gemm g{HB, (const bf16*)(ws + WS_W1D), M, DM, DFF}; StaticOrder S; S.init(M, DM, G, (int)blockIdx.x); pg8::EpiResid E{p.in[0], p.in[1] - (size_t)MPROMPT * DM, HRES, DM, 0.5f};
        pg8::gemm_phase<pg8::EpiResid, StaticOrder, true, true>(lds + RING_OFF, g, S, E); }
    SEAM(2);
    if (IN(3)) norm_phase(HRES, p.in[10], XN, gw, NGW, lane);
    SEAM(3);
    if (IN(4)) { Gemm g{XN, (const bf16*)(ws + WS_WIN), M, NWIN, DM}; StaticOrder S; S.init(M, NWIN, G, (int)blockIdx.x);
        pg8::EpiWin E{(bf16*)(ws + WS_QB), p.out + O_KP, p.out + O_KS, p.out + O_VP, p.out + O_VS, (bf16*)(ws + WS_PRW), (bf16*)(ws + WS_GSB), (bf16*)(ws + WS_GRW), p.out + O_SHP, p.out + O_SHS, p.in[12], p.in[13]};
        pg8::gemm_phase<pg8::EpiWin, StaticOrder, true, true>(lds + RING_OFF, g, S, E); }
    SEAM(4);
    if (IN(5)) { attn_phase(p, lds, gw, NGW, wave, lane); shift_phase(p, gw, NGW, lane); }
    SEAM(5);
    if (IN(6)) { Gemm g{(const bf16*)(ws + WS_ACAT), (const bf16*)(ws + WS_WLORA), M, NLORA, KLORA}; StaticOrder S; S.init(M, NLORA, G, (int)blockIdx.x);
        pg8::EpiLora E{(float*)(ws + WS_WD), (bf16*)(ws + WS_KP), (bf16*)(ws + WS_KKN), (bf16*)(ws + WS_BV), (bf16*)(ws + WS_G), (const bf16*)(ws + WS_XK), p.in[16], p.in[18], p.in[21], p.in[22]};
        pg8::gemm_phase<pg8::EpiLora, StaticOrder, true, true>(lds + RING_OFF, g, S, E); }
    SEAM(6);
    if (IN(7)) { for (int u = gw; u < 32 * NCH; u += NGW) scan_pass_a(p, u, lane); }
    SEAM(7);
    if (IN(8)) {
        if (wave == 0) for (int u = blockIdx.x; u < 128; u += G) scan_pass_b(p, u, lane);
        if (wave < 4) { const int vw = ((int)((blockIdx.x + G - (128 % G)) % G)) * 4 + wave;
            for (int u = vw; u < NBS * 16; u += G * 4) { const int s = u >> 4, h = u & 15;
                scan_pass_c(p, (size_t)MPROMPT + (size_t)s * TS, h, TS, p.in[4] + (size_t)u * 4096, p.out + O_WKVS + (size_t)u * 4096, lane); } }
    }
    SEAM(8);
    if (IN(9)) { for (int u = gw; u < 32 * NCH; u += NGW) { const int bh = u / NCH, c = u % NCH;
            scan_pass_c(p, (size_t)(bh >> 4) * TP + (size_t)c * CH, bh & 15, CH, (const float*)(ws + WS_SC) + (size_t)u * 4096, nullptr, lane); } }
    SEAM(9);
    if (IN(10)) { StaticOrder S; S.init(M, DM, G, (int)blockIdx.x);
        { Gemm g{(const bf16*)(ws + WS_AO), (const bf16*)(ws + WS_WSBO), M, DM, SBW}; pg8::EpiMerge<1> E{(const bf16*)(ws + WS_GSB), (float*)(ws + WS_H), XN};
          pg8::gemm_phase<pg8::EpiMerge<1>, StaticOrder, true, true>(lds + RING_OFF, g, S, E); }
        { Gemm g{(const bf16*)(ws + WS_YRW), (const bf16*)(ws + WS_WRWO), M, DM, RWW}; pg8::EpiMerge<2> E{(const bf16*)(ws + WS_GRW), (float*)(ws + WS_H), XN};
          pg8::gemm_phase<pg8::EpiMerge<2>, StaticOrder, true, true>(lds + RING_OFF, g, S, E); } }
    SEAM(10);
    if (IN(11)) { Gemm g{XN, (const bf16*)(ws + WS_WOUT), M, DM, DM}; StaticOrder S; S.init(M, DM, G, (int)blockIdx.x); pg8::EpiResid E{HRES, HRES, HRES, DM, 1.0f};
        pg8::gemm_phase<pg8::EpiResid, StaticOrder, true, true>(lds + RING_OFF, g, S, E); }
    SEAM(11);
    if (IN(12)) norm_phase(HRES, p.in[28], XN, gw, NGW, lane);
    SEAM(12);
    if (IN(13)) { Gemm g{XN, (const bf16*)(ws + WS_W2GU), M, NGU, DM}; StaticOrder S; S.init(M, NGU, G, (int)blockIdx.x); pg8::EpiGateUp E{HB, DFF};
        pg8::gemm_phase<pg8::EpiGateUp, StaticOrder, true, true>(lds + RING_OFF, g, S, E); }
    SEAM(13);
    if (IN(14)) { Gemm g{HB, (const bf16*)(ws + WS_W2D), M, DM, DFF}; StaticOrder S; S.init(M, DM, G, (int)blockIdx.x); pg8::EpiResid E{HRES, HRES, p.out + O_Y, DM, 0.5f};
        pg8::gemm_phase<pg8::EpiResid, StaticOrder, true, true>(lds + RING_OFF, g, S, E); }
#undef IN
#undef SEAM
}

extern "C" void kernel_launch(void* const* d_in, const int* in_sizes, int n_in, void* d_out, int out_size, void* d_ws, size_t ws_size, hipStream_t stream) {
    static int grid = 0;
    if (grid == 0) {
        if (n_in != 32 || (size_t)out_size != O_END || ws_size < WS_END) { fprintf(stderr, "kernel_launch: unexpected sizes n_in %d out %d ws %zu (need %zu)\n", n_in, out_size, ws_size, (size_t)WS_END); grid = -1; return; }
        int dev = 0, cus = 0, per_cu = 0;
        if (hipGetDevice(&dev) != hipSuccess || hipDeviceGetAttribute(&cus, hipDeviceAttributeMultiprocessorCount, dev) != hipSuccess) { grid = -1; return; }
        if (hipFuncSetAttribute((const void*)fwd_kernel, hipFuncAttributeMaxDynamicSharedMemorySize, LDS_BYTES) != hipSuccess) { fprintf(stderr, "kernel_launch: hipFuncSetAttribute failed\n"); grid = -1; return; }
        if (hipOccupancyMaxActiveBlocksPerMultiprocessor(&per_cu, (const void*)fwd_kernel, NWAVES * 64, LDS_BYTES) != hipSuccess || per_cu < 1) { fprintf(stderr, "kernel_launch: occupancy query says %d\n", per_cu); (void)hipGetLastError(); per_cu = 1; }
        grid = cus;
    }
    if (grid < 0) return;
    if (hipMemsetAsync((char*)d_ws + WS_CTL, 0, CTL_ZERO_BYTES, stream) != hipSuccess) return;
    Params p{};
    for (int i = 0; i < 32; ++i) p.in[i] = (const float*)d_in[i];
    p.out = (float*)d_out; p.ws = (unsigned char*)d_ws;
#if MK_SPLIT
    for (int ph = 0; ph < N_PHASES; ++ph) { p.ph_lo = ph; p.ph_hi = ph + 1; hipLaunchKernelGGL(fwd_kernel, dim3(grid), dim3(NWAVES * 64), LDS_BYTES, stream, p); }
#else
    p.ph_lo = 0; p.ph_hi = N_PHASES; hipLaunchKernelGGL(fwd_kernel, dim3(grid), dim3(NWAVES * 64), LDS_BYTES, stream, p);
#endif
}
```

```cpp
#include <hip/hip_runtime.h>
#include <cstdio>
#include <cstdint>
#ifndef ATT_SPLIT1
#define ATT_SPLIT1 4500
#define ATT_SPLIT2 6450
#endif
#ifndef MSCAN
#define MSCAN 1
#endif
namespace pg8 {
#define PG8_LAS __attribute__((address_space(3)))
typedef unsigned short bf16_t;
typedef short bf16x8 __attribute__((ext_vector_type(8)));
typedef float f32x4 __attribute__((ext_vector_type(4)));
typedef unsigned u32x4 __attribute__((ext_vector_type(4)));
constexpr int BM = 256, BK = 64, HALF = 128, HTB = HALF * BK * 2  , STAGE_BYTES = 8 * HTB, NXCD = 8, WGM = 8;

__host__ __device__ __forceinline__ int lds_byte(int r, int c) { const int st = (r >> 4) * 2 + (c >> 5), rr = r & 15, cc = c & 31, ob = rr * 64 + cc * 2; return st * 1024 + (ob ^ (((ob >> 9) & 1) << 5)); }
__host__ __device__ __forceinline__ void stage_rc(int b, int& R, int& C) { const int st = b / 1024, sb = b % 1024, swz = sb ^ (((sb >> 9) & 1) << 5); R = (st >> 1) * 16 + swz / 64; C = (st & 1) * 32 + (swz % 64) / 2; }
__host__ __device__ __forceinline__ int perm32(int rho) { const int n = rho >> 4, i = rho & 15; return 8 * (i >> 2) + 4 * n + (i & 3); }

struct Unit { int pm, pn, kt0, nkt; };
struct Gemm { const bf16_t* A; const bf16_t* Bt; int M, N, K; };

__host__ __device__ __forceinline__ int tile_of(int L, int nM, int nN) {
    const int nwg = nM * nN; int wgid = L; { const int q = nwg / NXCD, r = nwg % NXCD, xcd = wgid % NXCD, off = wgid / NXCD; wgid = (xcd < r ? xcd * (q + 1) : r * (q + 1) + (xcd - r) * q) + off; }
    const int wgm = nN <= 8 ? 4 : WGM;
    const int nig = wgm * nN, gid = wgid / nig, fm = gid * wgm, gsz = (nM - fm) < wgm ? (nM - fm) : wgm;
    return (fm + ((wgid % nig) % gsz)) | (((wgid % nig) / gsz) << 16);
}
constexpr int GRID = 256;
template <int M_, int N_, int K_, bool SPLIT = false, int NMUL = 1> struct StaticOrderT {
    static constexpr int nM = M_ / BM, nN = N_ / BM, nwg = nM * nN, nt = K_ / BK, full = nwg / GRID, R = nwg - full * GRID;
    static constexpr int SF0 = (SPLIT && R > 0 && GRID % R == 0 && R % NXCD == 0) ? GRID / R : 1;
    static constexpr int SF = (SF0 > 1 && nt % SF0 == 0 && ((nt / SF0) & 1) == 0) ? SF0 : 1;
    static constexpr int TAIL_UNITS = SF > 1 ? R : 0;
    int c;
    __host__ __device__ void init(int c_) { c = c_; }
    __host__ __device__ bool next(int i, Unit& u) const {
        const bool tail = SF > 1 && i == full;
        const int L = tail ? full * GRID + (c % NXCD) + NXCD * ((c / NXCD) / SF) : i * GRID + c;
        if (!tail && (L >= nwg || (SF > 1 && i > full))) return false;
        const int t = tile_of(L, nM, nN);
        Unit r; r.pm = t & 0xffff; r.pn = NMUL == 1 ? (t >> 16) : ((t >> 16) * NMUL) % nN; r.nkt = tail ? nt / SF : nt; r.kt0 = tail ? ((c / NXCD) % SF) * (nt / SF) : 0; u = r; return true;
    }
    __device__ __forceinline__ void a_ready(const Unit&, int) const {}
    __device__ __forceinline__ void done(const Unit&, int) const {}
};
template <int WHICH, int M_, int N_, int K_> struct MergeOrderT {
    static constexpr int nM = M_ / BM, nN = N_ / BM, nt = K_ / BK, FULL = (nM * nN) / GRID, R = nM * nN - FULL * GRID;
    static_assert(FULL == 2 && R == 64, "deal written for 2.25 rounds");
    int c; unsigned* flags;
    __device__ __forceinline__ void init(int c_, unsigned* f) { c = c_; flags = f; }
    __device__ __forceinline__ int tileL(int i) const {
        if (WHICH == 1) { if (c < R) return i == 0 ? FULL * GRID + c : (i <= FULL ? (i - 1) * GRID + c : -1); return i < FULL ? i * GRID + c : -1; }
        if (i < FULL) return i * GRID + c;
        return (i == FULL && c >= R && c < 2 * R) ? FULL * GRID + c - R : -1; }
    __device__ __forceinline__ bool next(int i, Unit& u) const {
        const int L = tileL(i); if (L < 0) return false;
        const int t = tile_of(L, nM, nN); Unit r; r.pm = t & 0xffff; r.pn = t >> 16; r.kt0 = 0; r.nkt = nt; u = r; return true; }
    __device__ __forceinline__ void a_ready(const Unit&, int i) const {
        if (WHICH != 2 || i != FULL) return;
        unsigned* f = flags + (c - R) * 32;
        for (int spin = 0; spin < 200000; ++spin) { if (__hip_atomic_load(f, __ATOMIC_RELAXED, __HIP_MEMORY_SCOPE_AGENT) != 0u) break; __builtin_amdgcn_s_sleep(8); }
        __builtin_amdgcn_fence(__ATOMIC_ACQUIRE, "agent");
    }
    __device__ __forceinline__ void done(const Unit&, int i) const {
        if (WHICH != 1 || c >= R || i != 0) return;
        asm volatile("s_waitcnt vmcnt(0)" ::: "memory");
        __builtin_amdgcn_s_barrier();
        if (threadIdx.x == 0) { __builtin_amdgcn_fence(__ATOMIC_RELEASE, "agent"); asm volatile("s_waitcnt vmcnt(0)" ::: "memory");
            __hip_atomic_store(flags + c * 32, 1u, __ATOMIC_RELAXED, __HIP_MEMORY_SCOPE_AGENT); }
    }
};
template <int M_> struct LoraOrderT {
    static constexpr int nM = M_ / BM, nN = 12, nwg = nM * nN;
    int c;
    __host__ __device__ void init(int c_) { c = c_; }
    __host__ __device__ bool next(int i, Unit& u) const {
        const int L = i * GRID + c; if (L >= nwg) return false;
        const int t = tile_of(L, nM, nN); Unit r; r.pm = t & 0xffff; r.pn = t >> 16; const int type = r.pn >> 2; r.kt0 = type == 0 ? 0 : (type == 1 ? 2 : 4); r.nkt = type == 2 ? 4 : 2; u = r; return true;
    }
    __device__ __forceinline__ void a_ready(const Unit&, int) const {}
    __device__ __forceinline__ void done(const Unit&, int) const {}
};

typedef float f32x2_t __attribute__((ext_vector_type(2))); typedef __bf16 bf16x2_t __attribute__((ext_vector_type(2)));
__device__ __forceinline__ unsigned cvt_pk_bf16(float lo, float hi) { const f32x2_t v = {lo, hi}; const bf16x2_t b = __builtin_convertvector(v, bf16x2_t); return __builtin_bit_cast(unsigned, b); }
typedef unsigned u32x2 __attribute__((ext_vector_type(2)));
__device__ __forceinline__ u32x4 pack8(const f32x4 a, const f32x4 b) { u32x4 w; w.x = cvt_pk_bf16(a[0], a[1]); w.y = cvt_pk_bf16(a[2], a[3]); w.z = cvt_pk_bf16(b[0], b[1]); w.w = cvt_pk_bf16(b[2], b[3]); return w; }
__device__ __forceinline__ float bflo(unsigned w) { return __uint_as_float(w << 16); }
__device__ __forceinline__ float bfhi(unsigned w) { return __uint_as_float(w & 0xffff0000u); }
__device__ __forceinline__ void unpack8(const u32x4 w, f32x4& a, f32x4& b) { a = (f32x4){bflo(w.x), bfhi(w.x), bflo(w.y), bfhi(w.y)}; b = (f32x4){bflo(w.z), bfhi(w.z), bflo(w.w), bfhi(w.w)}; }
__device__ __forceinline__ float xsum16(float x) { const auto r = __builtin_amdgcn_permlane16_swap(__float_as_uint(x), __float_as_uint(x), false, false); return __uint_as_float(r[0]) + __uint_as_float(r[1]); }
__device__ __forceinline__ float xsum32(float x) { const auto r = __builtin_amdgcn_permlane32_swap(__float_as_uint(x), __float_as_uint(x), false, false); return __uint_as_float(r[0]) + __uint_as_float(r[1]); }
__device__ __forceinline__ float sigm(float x) { return __builtin_amdgcn_rcpf(1.0f + __expf(-x)); }
__device__ __forceinline__ f32x4 sigm4(const f32x4 x) { return (f32x4){sigm(x[0]), sigm(x[1]), sigm(x[2]), sigm(x[3])}; }
constexpr int MP = 16384;

struct EpiGateUp {
    static constexpr bool PERM = true, AFTER_DRAIN = false;
    bf16_t* H; int ldh; const float* ss; int tiledM;
    __device__ __forceinline__ void operator()(const f32x4 (&acc)[2][2][4][2], const Unit& u, int wr, int wc, int fr, int fq) const {
        const int row0 = u.pm * BM + wr * 64 + fr, col0 = u.pn * 128 + wc * 32 + 8 * fq;
#pragma unroll
        for (int ai = 0; ai < 2; ++ai)
#pragma unroll
            for (int m = 0; m < 4; ++m) { const int row = row0 + ai * HALF + m * 16; bf16_t* rowp = tiledM ? H + ((size_t)(col0 >> 6) * tiledM + row) * 64 + (col0 & 63) : H + (size_t)row * ldh + col0;
                const float rs = ss ? __builtin_amdgcn_rsqf(ss[row] * (1.0f / 2048.0f) + 1e-6f) : 1.0f;
                const f32x4 g0 = acc[ai][0][m][0] * rs, g1 = acc[ai][0][m][1] * rs, u0 = acc[ai][1][m][0] * rs, u1 = acc[ai][1][m][1] * rs;
                const f32x4 h0 = g0 * sigm4(g0) * u0, h1 = g1 * sigm4(g1) * u1;
                *(u32x4*)rowp = pack8(h0, h1); }
    }
};
template <bool BASE_BF16, bool OUT_BF16> struct EpiResid {
    static constexpr bool PERM = true, AFTER_DRAIN = false;
    const void* b0; const void* b1; void* out; int ld; float scale; int ntfull; float* part; int uu; float* ss;
    __device__ __forceinline__ void operator()(const f32x4 (&acc)[2][2][4][2], const Unit& u, int wr, int wc, int fr, int fq) const {
        if (u.nkt == ntfull) {
            const void* base = (u.pm * BM < MP) ? b0 : b1;
            const int row0 = u.pm * BM + wr * 64 + fr, col0 = u.pn * BM + wc * 32 + 8 * fq;
#pragma unroll
            for (int ai = 0; ai < 2; ++ai) { f32x4 bs[4][2][2];
#pragma unroll
                for (int m = 0; m < 4; ++m) { const size_t off = (size_t)(row0 + ai * HALF + m * 16) * ld + col0;
#pragma unroll
                    for (int bj = 0; bj < 2; ++bj) {
                        if (BASE_BF16) unpack8(*(const u32x4*)((const bf16_t*)base + off + bj * HALF), bs[m][bj][0], bs[m][bj][1]);
                        else { bs[m][bj][0] = *(const f32x4*)((const float*)base + off + bj * HALF); bs[m][bj][1] = *(const f32x4*)((const float*)base + off + bj * HALF + 4); } } }
#pragma unroll
                for (int m = 0; m < 4; ++m) { const size_t off = (size_t)(row0 + ai * HALF + m * 16) * ld + col0; float sq = 0.f;
#pragma unroll
                    for (int bj = 0; bj < 2; ++bj) { const f32x4 v0 = bs[m][bj][0] + acc[ai][bj][m][0] * scale, v1 = bs[m][bj][1] + acc[ai][bj][m][1] * scale;
                        sq += (v0[0] * v0[0] + v0[1] * v0[1]) + (v0[2] * v0[2] + v0[3] * v0[3]) + (v1[0] * v1[0] + v1[1] * v1[1]) + (v1[2] * v1[2] + v1[3] * v1[3]);
                        if (OUT_BF16) *(u32x4*)((bf16_t*)out + off + bj * HALF) = pack8(v0, v1);
                        else { *(f32x4*)((float*)out + off + bj * HALF) = v0; *(f32x4*)((float*)out + off + bj * HALF + 4) = v1; } }
                    if (ss) { sq = xsum32(xsum16(sq)); if (fq == 0) unsafeAtomicAdd(ss + row0 + ai * HALF + m * 16, sq); } }
                asm volatile("" ::: "memory"); }
        } else {
            bf16_t* pp = (bf16_t*)part + (size_t)(uu * 4 + u.kt0 / u.nkt) * 65536 + (wr * 64 + fr) * 256 + wc * 32 + 8 * fq;
#pragma unroll
            for (int ai = 0; ai < 2; ++ai)
#pragma unroll
                for (int m = 0; m < 4; ++m)
#pragma unroll
                    for (int bj = 0; bj < 2; ++bj) *(u32x4*)(pp + (ai * HALF + m * 16) * 256 + bj * HALF) = pack8(acc[ai][bj][m][0], acc[ai][bj][m][1]);
        }
    }
};
struct EpiWin {
    static constexpr bool PERM = true, AFTER_DRAIN = false;
    bf16_t* Qb; float* Kp; float* Ks; float* Vp; float* Vs; bf16_t* PRW; unsigned char* GSB; unsigned char* GRW; float* SHp;
     float* SHs; const float* qg; const float* kg; const float* ss;
    __device__ __forceinline__ void operator()(const f32x4 (&acc)[2][2][4][2], const Unit& u, int wr, int wc, int fr, int fq) const {
        const int pn = u.pn, rowb = u.pm * BM + wr * 64 + fr; const bool prompt = u.pm * BM < MP;
        float rsr[2][4];
#pragma unroll
        for (int ai = 0; ai < 2; ++ai)
#pragma unroll
            for (int m = 0; m < 4; ++m) rsr[ai][m] = __builtin_amdgcn_rsqf(ss[rowb + ai * HALF + m * 16] * (1.0f / 2048.0f) + 1e-6f);
#define ACCS(ai, bj, m, n) (acc[ai][bj][m][n] * rsr[ai][m])
        if (pn < 8) {
            const bool isq = pn < 4; const int head = 4 * (pn & 3) + wc; const float* gain = isq ? qg : kg;
            f32x4 gv[2][2];
#pragma unroll
            for (int bj = 0; bj < 2; ++bj)
#pragma unroll
                for (int n = 0; n < 2; ++n) gv[bj][n] = *(const f32x4*)(gain + 32 * bj + 8 * fq + 4 * n);
#pragma unroll
            for (int ai = 0; ai < 2; ++ai)
#pragma unroll
                for (int m = 0; m < 4; ++m) { const int row = rowb + ai * HALF + m * 16; float ss = 0.f;
#pragma unroll
                    for (int bj = 0; bj < 2; ++bj)
#pragma unroll
                        for (int n = 0; n < 2; ++n) { const f32x4 x = ACCS(ai, bj, m, n); ss += (x[0] * x[0] + x[1] * x[1]) + (x[2] * x[2] + x[3] * x[3]); }
                    ss = xsum32(xsum16(ss));
                    float rs = __builtin_amdgcn_rsqf(ss * (1.0f / 64.0f) + 1e-6f); if (isq) rs *= 0.125f;
#pragma unroll
                    for (int bj = 0; bj < 2; ++bj) { const f32x4 v0 = ACCS(ai, bj, m, 0) * gv[bj][0] * rs, v1 = ACCS(ai, bj, m, 1) * gv[bj][1] * rs; const int col = head * 64 + 32 * bj + 8 * fq;
                        if (isq) *(u32x4*)(Qb + (size_t)row * 1024 + col) = pack8(v0, v1);
                        else { float* kp = (prompt ? Kp + (size_t)row * 1024 : Ks + (size_t)(row - MP) * 1024) + col; *(f32x4*)kp = v0; *(f32x4*)(kp + 4) = v1; } } }
        } else if (pn < 12) {
#pragma unroll
            for (int ai = 0; ai < 2; ++ai)
#pragma unroll
                for (int m = 0; m < 4; ++m) { const int row = rowb + ai * HALF + m * 16;
#pragma unroll
                    for (int bj = 0; bj < 2; ++bj) { const int col = (pn - 8) * 256 + bj * HALF + wc * 32 + 8 * fq; float* vp = (prompt ? Vp + (size_t)row * 1024 : Vs + (size_t)(row - MP) * 1024) + col;
                        *(f32x4*)vp = ACCS(ai, bj, m, 0); *(f32x4*)(vp + 4) = ACCS(ai, bj, m, 1); } }
        } else if (pn < 26) {
#pragma unroll
            for (int ai = 0; ai < 2; ++ai)
#pragma unroll
                for (int m = 0; m < 4; ++m) { const int row = rowb + ai * HALF + m * 16;
                    const bool last = prompt ? ((row & 8191) == 8191) : ((row & 63) == 63);
#pragma unroll
                    for (int bj = 0; bj < 2; ++bj) { const int col = (pn - 12) * 256 + bj * HALF + wc * 32 + 8 * fq;
                        *(u32x4*)(PRW + (size_t)row * 3584 + col) = pack8(ACCS(ai, bj, m, 0), ACCS(ai, bj, m, 1));
                        if (last && col < 3520) { float* sp = (prompt ? SHp + (size_t)(row >> 13) * 3520 : SHs + (size_t)((row - MP) >> 6) * 3520) + col; *(f32x4*)sp = ACCS(ai, bj, m, 0); *(f32x4*)(sp + 4) = ACCS(ai, bj, m, 1); } } }
        } else {
            unsigned char* G = pn < 34 ? GSB : GRW; const int t0 = pn < 34 ? 26 : 34;
#pragma unroll
            for (int ai = 0; ai < 2; ++ai)
#pragma unroll
                for (int m = 0; m < 4; ++m) { const int row = rowb + ai * HALF + m * 16;
#pragma unroll
                    for (int bj = 0; bj < 2; ++bj) { const int col = (pn - t0) * 256 + bj * HALF + wc * 32 + 8 * fq;
                        const f32x4 s0 = sigm4(ACCS(ai, bj, m, 0)) * 255.0f + 0.5f, s1 = sigm4(ACCS(ai, bj, m, 1)) * 255.0f + 0.5f;
                        u32x2 w; w.x = (unsigned)s0[0] | ((unsigned)s0[1] << 8) | ((unsigned)s0[2] << 16) | ((unsigned)s0[3] << 24); w.y = (unsigned)s1[0] | ((unsigned)s1[1] << 8) | ((unsigned)s1[2] << 16) | ((unsigned)s1[3] << 24);
                        *(u32x2*)(G + (size_t)row * 2048 + col) = w; } }
        }
    }
};
#undef ACCS
struct EpiLora {
    static constexpr bool PERM = true, AFTER_DRAIN = false;
    bf16_t* WD; bf16_t* KP; bf16_t* KKN; bf16_t* BV; bf16_t* G; const bf16_t* PRW; const float* muk; const float* shk; const float* w0; const float* a0; const float* k_k; const float* k_a;
    __device__ __forceinline__ void operator()(const f32x4 (&acc)[2][2][4][2], const Unit& u, int wr, int wc, int fr, int fq) const {
        const int pn = u.pn, type = pn >> 2, head = 4 * (pn & 3) + wc, rowb = u.pm * BM + wr * 64 + fr, colh = head * 64 + 8 * fq;
        if (type == 0) {
            f32x4 wv[2][2];
#pragma unroll
            for (int bj = 0; bj < 2; ++bj)
#pragma unroll
                for (int n = 0; n < 2; ++n) wv[bj][n] = *(const f32x4*)(w0 + colh + 32 * bj + 4 * n);
#pragma unroll
            for (int ai = 0; ai < 2; ++ai)
#pragma unroll
                for (int m = 0; m < 4; ++m) { const int row = rowb + ai * HALF + m * 16;
#pragma unroll
                    for (int bj = 0; bj < 2; ++bj) { f32x4 d[2];
#pragma unroll
                        for (int n = 0; n < 2; ++n) { const f32x4 x = acc[ai][bj][m][n] + wv[bj][n];
#pragma unroll
                            for (int e = 0; e < 4; ++e) { const float nx = -x[e]; const float sp = fmaxf(nx, 0.f) + __logf(1.0f + __expf(-fabsf(nx))); d[n][e] = __expf(-sp - 0.5f); } }
                        *(u32x4*)(WD + (size_t)row * 1024 + colh + 32 * bj) = pack8(d[0], d[1]); } }
        } else if (type == 1) {
#pragma unroll
            for (int ai = 0; ai < 2; ++ai)
#pragma unroll
                for (int m = 0; m < 4; ++m) { const int row = rowb + ai * HALF + m * 16; f32x4 al[2][2], kk[2][2]; float ss = 0.f;
                    asm volatile("" ::: "memory");
#pragma unroll
                    for (int bj = 0; bj < 2; ++bj) { f32x4 xk[2], pq[2]; const int cc0 = colh + 32 * bj;
                        unpack8(*(const u32x4*)(PRW + (size_t)row * 3584 + 1024 + cc0), xk[0], xk[1]);
                        const bool prompt = row < MP; const int tt = prompt ? (row & 8191) : ((row - MP) & 63);
                        if (tt != 0) unpack8(*(const u32x4*)(PRW + (size_t)(row - 1) * 3584 + 1024 + cc0), pq[0], pq[1]);
                        else if (prompt) { pq[0] = (f32x4){0.f, 0.f, 0.f, 0.f}; pq[1] = pq[0]; }
                        else { const float* sp = shk + (size_t)((row - MP) >> 6) * 3520 + cc0; pq[0] = *(const f32x4*)sp; pq[1] = *(const f32x4*)(sp + 4); }
                        xk[0] += (pq[0] - xk[0]) * *(const f32x4*)(muk + cc0); xk[1] += (pq[1] - xk[1]) * *(const f32x4*)(muk + cc0 + 4);
                        f32x4 kp[2];
#pragma unroll
                        for (int n = 0; n < 2; ++n) { const int cc = colh + 32 * bj + 4 * n;
                            al[bj][n] = sigm4(acc[ai][bj][m][n] + *(const f32x4*)(a0 + cc)); kk[bj][n] = xk[n] * *(const f32x4*)(k_k + cc); kp[n] = xk[n] * (1.0f + (al[bj][n] - 1.0f) * *(const f32x4*)(k_a + cc));
                            const f32x4 q = kk[bj][n]; ss += (q[0] * q[0] + q[1] * q[1]) + (q[2] * q[2] + q[3] * q[3]); }
                        *(u32x4*)(KP + (size_t)row * 1024 + colh + 32 * bj) = pack8(kp[0], kp[1]); }
                    ss = xsum32(xsum16(ss));
                    const float inv = __builtin_amdgcn_rsqf(fmaxf(ss, 1e-24f));
#pragma unroll
                    for (int bj = 0; bj < 2; ++bj) { const size_t off = (size_t)row * 1024 + colh + 32 * bj; const f32x4 n0 = kk[bj][0] * inv, n1 = kk[bj][1] * inv;
                        *(u32x4*)(KKN + off) = pack8(n0, n1); *(u32x4*)(BV + off) = pack8(n0 * al[bj][0], n1 * al[bj][1]); } }
        } else {
#pragma unroll
            for (int ai = 0; ai < 2; ++ai)
#pragma unroll
                for (int m = 0; m < 4; ++m) { const int row = rowb + ai * HALF + m * 16;
#pragma unroll
                    for (int bj = 0; bj < 2; ++bj) *(u32x4*)(G + (size_t)row * 1024 + colh + 32 * bj) = pack8(acc[ai][bj][m][0], acc[ai][bj][m][1]); }
        }
    }
};
template <int STEP> struct EpiMerge {
    static constexpr bool PERM = true, AFTER_DRAIN = false;
    const unsigned char* GATE; bf16_t* MPART; bf16_t* MERGED;
    __device__ __forceinline__ void operator()(const f32x4 (&acc)[2][2][4][2], const Unit& u, int wr, int wc, int fr, int fq) const {
        const int row0 = u.pm * BM + wr * 64 + fr, col0 = u.pn * BM + wc * 32 + 8 * fq;
#pragma unroll
        for (int ai = 0; ai < 2; ++ai) { u32x2 gw[4][2]; u32x4 mp[4][2];
#pragma unroll
            for (int m = 0; m < 4; ++m) { const size_t off = (size_t)(row0 + ai * HALF + m * 16) * 2048 + col0;
#pragma unroll
                for (int bj = 0; bj < 2; ++bj) { gw[m][bj] = *(const u32x2*)(GATE + off + bj * HALF); if (STEP == 2) mp[m][bj] = *(const u32x4*)(MPART + off + bj * HALF); } }
#pragma unroll
            for (int m = 0; m < 4; ++m) { const size_t off = (size_t)(row0 + ai * HALF + m * 16) * 2048 + col0;
#pragma unroll
                for (int bj = 0; bj < 2; ++bj) { const unsigned wa = gw[m][bj].x, wb = gw[m][bj].y;
                    const f32x4 g0 = (f32x4){(float)(wa & 0xffu), (float)((wa >> 8) & 0xffu), (float)((wa >> 16) & 0xffu), (float)(wa >> 24)} * (1.0f / 255.0f),
                                g1 = (f32x4){(float)(wb & 0xffu), (float)((wb >> 8) & 0xffu), (float)((wb >> 16) & 0xffu), (float)(wb >> 24)} * (1.0f / 255.0f);
                    f32x4 v0 = g0 * acc[ai][bj][m][0], v1 = g1 * acc[ai][bj][m][1];
                    if (STEP == 1) *(u32x4*)(MPART + off + bj * HALF) = pack8(v0, v1);
                    else { f32x4 p0, p1; unpack8(mp[m][bj], p0, p1); v0 += p0; v1 += p1; *(u32x4*)(MERGED + off + bj * HALF) = pack8(v0, v1); } } }
            asm volatile("" ::: "memory"); }
    }
};

template <class Epi, class Sched, bool ALIGN_EPI = false, bool SP2 = false, bool TILED = false>
__device__ __forceinline__ void gemm_phase(PG8_LAS unsigned char* lds, const Gemm g, const Sched& S, const Epi& E) {
    const int tid = threadIdx.x, wid = __builtin_amdgcn_readfirstlane(tid >> 6), lane = tid & 63, wr = wid >> 2, wc = wid & 3, fr = lane & 15, fq = lane >> 4;
    const int K = g.K;
    unsigned voffA[2], voffB[2];
#pragma unroll
    for (int i = 0; i < 2; ++i) { int R, C; stage_rc(tid * 16 + i * 8192, R, C); const int Rb = Epi::PERM ? ((R & ~31) + perm32(R & 31)) : R;
        voffA[i] = (unsigned)(R * (TILED ? 64 : K) + C) * 2u; voffB[i] = (unsigned)(Rb * (TILED ? 64 : K) + C) * 2u; }
    const size_t kstepA = TILED ? (size_t)g.M * 128 : (size_t)(BK * 2), kstepB = TILED ? (size_t)g.N * 128 : (size_t)(BK * 2);
    const size_t hstepA = (size_t)HALF * (TILED ? 64 : K) * 2, hstepB = hstepA;
    const size_t tstepA = 2 * hstepA, tstepB = 2 * hstepB;
    const unsigned ldsw = (unsigned)wid * 1024u;
    const int aoff = lds_byte(wr * 64 + fr, fq * 8), boff = lds_byte(wc * 32 + fr, fq * 8);
#define PG8_SA(b, h) (((b) * 2 + (h)) * HTB)
#define PG8_SB(b, h) ((4 + (b) * 2 + (h)) * HTB)
#define PG8_STAGE(bufoff, gbase, voff) do { _Pragma("unroll") for (int _i = 0; _i < 2; ++_i) \
        __builtin_amdgcn_global_load_lds((const unsigned*)((const char*)(gbase) + (voff)[_i]), (PG8_LAS unsigned*)(lds + (bufoff) + ldsw + _i * 8192), 16, 0, 0); } while (0)
#define PG8_LDA(dst, b, h) do { _Pragma("unroll") for (int m = 0; m < 4; ++m) _Pragma("unroll") for (int k = 0; k < 2; ++k) dst[m][k] = *(const PG8_LAS bf16x8*)(lds + PG8_SA(b, h) + aoff + m * 2048 + k * 1024); } while (0)
#define PG8_LDB(dst, b, h) do { _Pragma("unroll") for (int n = 0; n < 2; ++n) _Pragma("unroll") for (int k = 0; k < 2; ++k) dst[n][k] = *(const PG8_LAS bf16x8*)(lds + PG8_SB(b, h) + boff + n * 2048 + k * 1024); } while (0)
#define PG8_MMA(ai, bj, At, Bt) do { __builtin_amdgcn_s_setprio(1); _Pragma("unroll") for (int m = 0; m < 4; ++m) _Pragma("unroll") for (int n = 0; n < 2; ++n) _Pragma("unroll") for (int k = 0; k < 2; ++k) \
        acc[ai][bj][m][n] = __builtin_amdgcn_mfma_f32_16x16x32_bf16(Bt[n][k], At[m][k], acc[ai][bj][m][n], 0, 0, 0); __builtin_amdgcn_s_setprio(0); } while (0)
#define PG8_WAIT_V(n) asm volatile("s_waitcnt vmcnt(" #n ")" ::: "memory")
#define PG8_WAIT_L(n) asm volatile("s_waitcnt lgkmcnt(" #n ")" ::: "memory")
#define PG8_BAR __builtin_amdgcn_s_barrier()
#define PG8_SCHED __builtin_amdgcn_sched_barrier(0)
    Unit cur, nxt; int ui = 0;
    if (!S.next(0, cur)) return;
    f32x4 acc[2][2][4][2];
#pragma unroll
    for (int a = 0; a < 2; ++a)
#pragma unroll
        for (int b = 0; b < 2; ++b)
#pragma unroll
            for (int m = 0; m < 4; ++m)
#pragma unroll
                for (int n = 0; n < 2; ++n) acc[a][b][m][n] = (f32x4){0.f, 0.f, 0.f, 0.f};
    bf16x8 At[4][2], B0[2][2], B1[2][2];
    const char* cA = (const char*)g.A + (size_t)cur.pm * tstepA + (size_t)cur.kt0 * kstepA; const char* cB = (const char*)g.Bt + (size_t)cur.pn * tstepB + (size_t)cur.kt0 * kstepB;
    S.a_ready(cur, 0);
    if constexpr (SP2) {
        PG8_STAGE(PG8_SB(0, 0), cB, voffB); PG8_STAGE(PG8_SB(0, 1), cB + hstepB, voffB); PG8_STAGE(PG8_SA(0, 0), cA, voffA); PG8_STAGE(PG8_SA(0, 1), cA + hstepA, voffA);
        if (wr == 1) PG8_BAR;
        PG8_WAIT_V(2); PG8_BAR;
        PG8_STAGE(PG8_SB(1, 0), cB + kstepB, voffB); PG8_STAGE(PG8_SA(1, 0), cA + kstepA, voffA); PG8_STAGE(PG8_SB(1, 1), cB + hstepB + kstepB, voffB);
        PG8_WAIT_V(6); PG8_BAR;
    } else {
        PG8_STAGE(PG8_SB(0, 0), cB, voffB); PG8_STAGE(PG8_SA(0, 0), cA, voffA); PG8_STAGE(PG8_SB(0, 1), cB + hstepB, voffB); PG8_STAGE(PG8_SA(0, 1), cA + hstepA, voffA);
        if (wr == 1) PG8_BAR;
        PG8_WAIT_V(4); PG8_BAR;
        PG8_STAGE(PG8_SB(1, 0), cB + kstepB, voffB); PG8_STAGE(PG8_SA(1, 0), cA + kstepA, voffA); PG8_STAGE(PG8_SB(1, 1), cB + hstepB + kstepB, voffB);
        PG8_WAIT_V(6); PG8_BAR;
    }
    for (;;) {
        const bool has_next = S.next(ui + 1, nxt);
        const char* nA = has_next ? (const char*)g.A + (size_t)nxt.pm * tstepA + (size_t)nxt.kt0 * kstepA : cA; const char* nB = has_next ? (const char*)g.Bt + (size_t)nxt.pn * tstepB + (size_t)nxt.kt0 * kstepB : cB;
        const int nt = cur.nkt;
        for (int t = 0; t < nt; t += 2) {
            const bool last = (t == nt - 2);
            const char* a1 = cA + (size_t)(t + 1) * kstepA;
            const char* a2 = last ? nA : cA + (size_t)(t + 2) * kstepA; const char* b2 = last ? nB : cB + (size_t)(t + 2) * kstepB;
            const char* a3 = a2 + kstepA; const char* b3 = b2 + kstepB;
            if (last && has_next) S.a_ready(nxt, ui + 1);
            if constexpr (SP2) {
            PG8_LDB(B0, 0, 0); PG8_LDB(B1, 0, 1); PG8_SCHED; PG8_LDA(At, 0, 0); PG8_STAGE(PG8_SA(1, 1), a1 + hstepA, voffA);
            PG8_WAIT_V(8); PG8_WAIT_L(0); PG8_BAR; PG8_MMA(0, 0, At, B0); PG8_MMA(0, 1, At, B1); PG8_BAR; PG8_SCHED;
            PG8_LDA(At, 0, 1); PG8_STAGE(PG8_SB(0, 0), b2, voffB); PG8_STAGE(PG8_SB(0, 1), b2 + hstepB, voffB); PG8_STAGE(PG8_SA(0, 0), a2, voffA);
            PG8_WAIT_V(8); PG8_WAIT_L(0); PG8_BAR; PG8_MMA(1, 0, At, B0); PG8_MMA(1, 1, At, B1); PG8_BAR; PG8_SCHED;
            PG8_LDB(B0, 1, 0); PG8_LDB(B1, 1, 1); PG8_SCHED; PG8_LDA(At, 1, 0); PG8_STAGE(PG8_SA(0, 1), a2 + hstepA, voffA);
            PG8_WAIT_V(8); PG8_WAIT_L(0); PG8_BAR; PG8_MMA(0, 0, At, B0); PG8_MMA(0, 1, At, B1); PG8_BAR; PG8_SCHED;
            PG8_LDA(At, 1, 1); PG8_STAGE(PG8_SB(1, 0), b3, voffB); PG8_STAGE(PG8_SB(1, 1), b3 + hstepB, voffB); PG8_STAGE(PG8_SA(1, 0), a3, voffA);
            PG8_WAIT_V(8); PG8_WAIT_L(0); PG8_BAR; PG8_MMA(1, 0, At, B0); PG8_MMA(1, 1, At, B1); PG8_BAR; PG8_SCHED;
            } else {
            PG8_LDB(B0, 0, 0); PG8_SCHED; PG8_LDA(At, 0, 0); PG8_STAGE(PG8_SA(1, 1), a1 + hstepA, voffA);
            PG8_WAIT_L(8); PG8_BAR; PG8_WAIT_L(0); PG8_MMA(0, 0, At, B0); PG8_BAR; PG8_SCHED;
            PG8_LDB(B1, 0, 1); PG8_STAGE(PG8_SB(0, 0), b2, voffB);
            PG8_BAR; PG8_WAIT_L(0); PG8_MMA(0, 1, At, B1); PG8_BAR;
            PG8_LDA(At, 0, 1); PG8_STAGE(PG8_SA(0, 0), a2, voffA);
            PG8_BAR; PG8_WAIT_L(0); PG8_MMA(1, 0, At, B0); PG8_BAR; PG8_SCHED;
            PG8_STAGE(PG8_SB(0, 1), b2 + hstepB, voffB);
            PG8_WAIT_V(6); PG8_BAR; PG8_MMA(1, 1, At, B1); PG8_BAR;
            PG8_LDB(B0, 1, 0); PG8_SCHED; PG8_LDA(At, 1, 0); PG8_STAGE(PG8_SA(0, 1), a2 + hstepA, voffA);
            PG8_WAIT_L(8); PG8_BAR; PG8_WAIT_L(0); PG8_MMA(0, 0, At, B0); PG8_BAR; PG8_SCHED;
            PG8_LDB(B1, 1, 1); PG8_STAGE(PG8_SB(1, 0), b3, voffB);
            PG8_BAR; PG8_WAIT_L(0); PG8_MMA(0, 1, At, B1); PG8_BAR;
            PG8_LDA(At, 1, 1); PG8_STAGE(PG8_SA(1, 0), a3, voffA);
            PG8_BAR; PG8_WAIT_L(0); PG8_MMA(1, 0, At, B0); PG8_BAR; PG8_SCHED;
            PG8_STAGE(PG8_SB(1, 1), b3 + hstepB, voffB);
            PG8_WAIT_V(6); PG8_BAR; PG8_MMA(1, 1, At, B1); PG8_BAR;
            }
        }
        if constexpr (ALIGN_EPI) { if (wr == 0) PG8_BAR; }
        if constexpr (!Epi::AFTER_DRAIN) { E(acc, cur, wr, wc, fr, fq); S.done(cur, ui); }
        if (!has_next) break;
#pragma unroll
        for (int a = 0; a < 2; ++a)
#pragma unroll
            for (int b = 0; b < 2; ++b)
#pragma unroll
                for (int m = 0; m < 4; ++m)
#pragma unroll
                    for (int n = 0; n < 2; ++n) acc[a][b][m][n] = (f32x4){0.f, 0.f, 0.f, 0.f};
        cur = nxt; cA = nA; cB = nB; ++ui;
        if constexpr (ALIGN_EPI) { if (wr == 1) PG8_BAR; }
    }
    PG8_WAIT_V(0);
    if constexpr (!ALIGN_EPI) { if (wr == 0) PG8_BAR; }
    PG8_BAR;
    if constexpr (Epi::AFTER_DRAIN) { E.fused(acc, cur, wr, wc, fr, fq, lds, wid, lane); S.done(cur, ui); }
#undef PG8_SA
#undef PG8_SB
#undef PG8_STAGE
#undef PG8_LDA
#undef PG8_LDB
#undef PG8_MMA
#undef PG8_WAIT_V
#undef PG8_WAIT_L
#undef PG8_BAR
#undef PG8_SCHED
}
}
#define GAS __attribute__((address_space(1)))
#define LAS __attribute__((address_space(3)))
typedef unsigned short bf16;
typedef unsigned v4u __attribute__((ext_vector_type(4)));
typedef float f32x4 __attribute__((ext_vector_type(4)));
typedef short bf16x8 __attribute__((ext_vector_type(8)));
typedef GAS unsigned gu32;
typedef GAS unsigned long long gu64;
#define RLX_AGENT __ATOMIC_RELAXED, __HIP_MEMORY_SCOPE_AGENT
#define LDS_WAIT() asm volatile("s_waitcnt lgkmcnt(0)" ::: "memory")
#define VM_WAIT() asm volatile("s_waitcnt vmcnt(0)" ::: "memory")
__device__ __forceinline__ unsigned long long rt() { return __builtin_amdgcn_s_memrealtime(); }
__device__ __forceinline__ unsigned f2bf(float f) { unsigned u = __builtin_bit_cast(unsigned, f); return (u + 0x7fffu + ((u >> 16) & 1u)) >> 16; }
__device__ __forceinline__ unsigned pk2(float lo, float hi) { return f2bf(lo) | (f2bf(hi) << 16); }

#define XB_TMO      128
#define XB_XCNT(j)  (256  + 64 * (j))
#define XB_XSUB(j)  (1280 + 64 * (j))
#define XB_XGEN(j)  (2304 + 64 * (j))
#define XB_TOP      3328
#define XB_TOPGEN   3392
#define XCD_BAR_WORDS 3456
#define XB_SPIN_CAP (1u << 18)

__device__ __forceinline__ unsigned xb_ld(unsigned* p)              { return __hip_atomic_load(p, __ATOMIC_RELAXED, __HIP_MEMORY_SCOPE_AGENT); }
__device__ __forceinline__ unsigned xb_add(unsigned* p, unsigned v) { return __hip_atomic_fetch_add(p, v, __ATOMIC_RELAXED, __HIP_MEMORY_SCOPE_AGENT); }
__device__ __forceinline__ unsigned xb_xcc_id() { return (unsigned)__builtin_amdgcn_s_getreg((3 << 11) | 20) & 0xFu; }
#define XB_SPIN(cond, bar) do { unsigned _sp = 0; while (cond) { __builtin_amdgcn_s_sleep(1); \
    if ((++_sp & 255u) == 0u) { if (xb_ld(&(bar)[XB_TMO])) break; if (_sp > XB_SPIN_CAP) { atomicAdd(&(bar)[XB_TMO], 1u); break; } } } } while (0)

struct XcdBarrier {
    unsigned* bar; unsigned x;
    volatile LAS unsigned* st;
};

__device__ __forceinline__ XcdBarrier xcd_barrier_post(unsigned* bar, volatile LAS unsigned* st) {
    XcdBarrier b; b.bar = bar; b.x = xb_xcc_id(); b.st = st;
    if (threadIdx.x == 0) (void)xb_add(&bar[XB_XCNT(b.x)], 1u);
    return b;
}
__device__ __forceinline__ void xcd_barrier_complete(unsigned* bar, unsigned x, unsigned& nloc, unsigned& nx) {
    const unsigned G = gridDim.x * gridDim.y * gridDim.z;
    unsigned sum, cnt, mine, sp = 0u;
    for (;;) {
        sum = 0u; cnt = 0u; mine = 0u;
#pragma unroll
        for (unsigned j = 0; j < 16; ++j) { const unsigned c = xb_ld(&bar[XB_XCNT(j)]); sum += c; cnt += (c > 0u) ? 1u : 0u; mine = (j == x) ? c : mine; }
        if (sum == G) break;
        __builtin_amdgcn_s_sleep(1);
        if ((++sp & 255u) == 0u) { if (xb_ld(&bar[XB_TMO])) break; if (sp > XB_SPIN_CAP) { atomicAdd(&bar[XB_TMO], 1u); break; } }
    }
    nloc = mine > 0u ? mine : 1u; nx = cnt > 0u ? cnt : 1u;
}

__device__ __forceinline__ void xcd_barrier(const XcdBarrier& b) {
    asm volatile("s_waitcnt vmcnt(0)" ::: "memory");
    __syncthreads();
    if (threadIdx.x == 0) {
        unsigned* bar = b.bar;
        __builtin_amdgcn_s_waitcnt(0);
        unsigned nloc = b.st[0], nx = b.st[1];
        if (nloc == 0u) { xcd_barrier_complete(bar, b.x, nloc, nx); b.st[0] = nloc; b.st[1] = nx; }
        const unsigned old = xb_add(&bar[XB_XSUB(b.x)], 1u);
        const unsigned gen = old / nloc;
        if (old + 1u == (gen + 1u) * nloc) {
            __builtin_amdgcn_fence(__ATOMIC_RELEASE, "agent");
            asm volatile("s_waitcnt vmcnt(0)" ::: "memory");
            const unsigned og = xb_add(&bar[XB_TOP], 1u);
            const unsigned tg = og / nx;
            if (og + 1u == (tg + 1u) * nx) xb_add(&bar[XB_TOPGEN], 1u);
            else XB_SPIN(xb_ld(&bar[XB_TOPGEN]) == tg, bar);
            __builtin_amdgcn_fence(__ATOMIC_ACQUIRE, "agent");
            xb_add(&bar[XB_XGEN(b.x)], 1u);
            asm volatile("s_waitcnt vmcnt(0)" ::: "memory");
        } else {
            XB_SPIN(xb_ld(&bar[XB_XGEN(b.x)]) == gen, bar);
            __builtin_amdgcn_fence(__ATOMIC_ACQUIRE, "agent");
            asm volatile("s_waitcnt vmcnt(0)" ::: "memory");
        }
    }
    __syncthreads();
}
constexpr int NWAVES = 8;
constexpr int DM = 2048, DFF = 5632, SBW = 1024, RWW = 1024, RWC = 3520, RWCP = 3584;
constexpr int TP = 8192, NBP = 2, TS = 64, NBS = 32, PAST = 4096;
constexpr int MPROMPT = NBP * TP, MSAMPLE = NBS * TS, M = MPROMPT + MSAMPLE;
constexpr int NGU = 2 * DFF;
constexpr int NWIN = 42 * 256;
constexpr int KLORA = 512, NLORA = 3072;
constexpr int CH = 256, NCH = TP / CH;
static_assert(M % 256 == 0 && MPROMPT % 256 == 0 && pg8::MP == MPROMPT, "row panels");
constexpr size_t O_Y = 0, O_KP = (size_t)M * DM, O_VP = O_KP + (size_t)MPROMPT * SBW, O_WKVP = O_VP + (size_t)MPROMPT * SBW, O_SHP = O_WKVP + (size_t)NBP * 16 * 4096,
                 O_KS = O_SHP + (size_t)NBP * RWC, O_VS = O_KS + (size_t)MSAMPLE * SBW, O_WKVS = O_VS + (size_t)MSAMPLE * SBW, O_SHS = O_WKVS + (size_t)NBS * 16 * 4096, O_END = O_SHS + (size_t)NBS * RWC;
static_assert(O_END == 77845376, "output size");
constexpr size_t MiB = 1u << 20;
constexpr size_t al256(size_t x) { return (x + 255) & ~(size_t)255; }
constexpr size_t WS_CTL = 0, CTL_ZERO_BYTES = 1 * MiB;
constexpr size_t WS_W1GU = 1 * MiB;
constexpr size_t WS_W1D  = WS_W1GU + (size_t)NGU * DM * 2;
constexpr size_t WS_W2GU = WS_W1D + (size_t)DM * DFF * 2;
constexpr size_t WS_W2D  = WS_W2GU + (size_t)NGU * DM * 2;
constexpr size_t WS_WIN  = WS_W2D + (size_t)DM * DFF * 2;
constexpr size_t WS_WSBO = WS_WIN + (size_t)NWIN * DM * 2;
constexpr size_t WS_WRWO = WS_WSBO + (size_t)DM * SBW * 2;
constexpr size_t WS_WOUT = WS_WRWO + (size_t)DM * RWW * 2;
constexpr size_t WS_WLORA = WS_WOUT + (size_t)DM * DM * 2;
constexpr size_t WS_XN   = al256(WS_WLORA + (size_t)NLORA * KLORA * 2);
constexpr size_t WS_H    = WS_XN + (size_t)M * DM * 2;
constexpr size_t WS_HRES = WS_H + (size_t)M * DFF * 2;
constexpr size_t WS_QB   = WS_HRES + (size_t)M * DM * 4;
constexpr size_t WS_PRW  = WS_QB + (size_t)M * SBW * 2;
constexpr size_t WS_GSB  = WS_PRW + (size_t)M * RWCP * 2;
constexpr size_t WS_GRW  = WS_GSB + (size_t)M * DM * 2;
constexpr size_t WS_AO   = WS_GRW + (size_t)M * DM * 2;
constexpr size_t WS_XR   = WS_AO + (size_t)M * SBW * 2;
constexpr size_t WS_XK   = WS_XR + (size_t)M * RWW * 2;
constexpr size_t WS_XV   = WS_XK + (size_t)M * RWW * 2;
constexpr size_t WS_ACAT = WS_XV + (size_t)M * RWW * 2;
constexpr size_t WS_WD   = WS_ACAT + (size_t)M * KLORA * 2;
constexpr size_t WS_KP   = WS_WD + (size_t)M * RWW * 4;
constexpr size_t WS_KKN  = WS_KP + (size_t)M * RWW * 2;
constexpr size_t WS_BV   = WS_KKN + (size_t)M * RWW * 2;
constexpr size_t WS_G    = WS_BV + (size_t)M * RWW * 2;
constexpr size_t WS_YRW  = WS_G + (size_t)M * RWW * 2;
constexpr size_t WS_PC   = WS_YRW + (size_t)M * RWW * 2;
constexpr size_t WS_UC   = WS_PC + (size_t)32 * NCH * 4096 * 4;
constexpr size_t WS_SC   = WS_UC + (size_t)32 * NCH * 4096 * 4;
constexpr size_t WS_PART = WS_SC + (size_t)32 * NCH * 4096 * 4;
constexpr size_t WS_END  = WS_PART + (size_t)64 * 4 * 65536 * 4;
static_assert((size_t)M * DM * 4 <= (size_t)M * DFF * 2, "MPART fits in H");
constexpr int CW_BAR = 4096, CW_ATTQ = 8192, CW_SS1 = 16384, CW_SS2 = 40960, CW_SS0 = 61440, CW_MFLAG = 100000;
static_assert(CW_SS1 + M <= CW_SS2 && CW_SS2 + M <= CW_SS0 && (size_t)(CW_SS0 + M) * 4 <= CTL_ZERO_BYTES, "row statistics inside the zeroed control region");
constexpr int RING_OFF = 0, RING_BYTES = 131072;
constexpr int LDSCTL_OFF = RING_BYTES, MISC_OFF = LDSCTL_OFF + 320;
constexpr int ATT2_OFF = LDSCTL_OFF + 512;
constexpr int LDS_BYTES = 151552;
static_assert(MISC_OFF + 128 <= ATT2_OFF && ATT2_OFF + 4 * 4608 <= LDS_BYTES && LDS_BYTES <= 160 * 1024 && pg8::STAGE_BYTES <= RING_BYTES, "LDS map");

struct Params {
    const float* in[32]; float* out; unsigned char* ws; int ph_lo, ph_hi;
};
typedef float f32x16 __attribute__((ext_vector_type(16)));
using pg8::u32x2;
__device__ __forceinline__ unsigned cvtpk(float lo, float hi) { return pg8::cvt_pk_bf16(lo, hi); }
__device__ __forceinline__ float bf_lo(unsigned w) { return __uint_as_float(w << 16); }
__device__ __forceinline__ float bf_hi(unsigned w) { return __uint_as_float(w & 0xffff0000u); }

template <int CTRL> __device__ __forceinline__ float dppf(float x) { return __builtin_bit_cast(float, __builtin_amdgcn_update_dpp(0, __builtin_bit_cast(int, x), CTRL, 0xf, 0xf, true)); }
__device__ __forceinline__ float red8(float x) {
    x += dppf<0xB1>(x);
    x += dppf<0x4E>(x);
    x += dppf<0x141>(x);
    return x;
}
using pg8::xsum16; using pg8::xsum32;
__device__ __forceinline__ float row16_sum(float x) {
    x = red8(x); x += dppf<0x128>(x); return x;
}
__device__ __forceinline__ float wave_sum(float x) { return xsum32(xsum16(row16_sum(x))); }
__device__ __forceinline__ float red_hi8(float x) {
    x += dppf<0x128>(x);
    return xsum32(xsum16(x));
}

__device__ __forceinline__ void p0_transpose_item(const float* W, int K, int N, bf16* WT, int vrow0, int k0, int n0, LAS float* scr, int lane, const float* kgain = nullptr, int tiledN = 0) {
    float tv[32];
#pragma unroll
    for (int i = 0; i < 32; ++i) tv[i] = W[(size_t)(k0 + 2 * i + (lane >> 5)) * N + n0 + (lane & 31)];
#pragma unroll
    for (int i = 0; i < 32; ++i) scr[(2 * i + (lane >> 5)) * 33 + (lane & 31)] = tv[i];
    LDS_WAIT(); asm volatile("" ::: "memory");
    const int c = lane & 7; f32x4 ga = (f32x4){1.f, 1.f, 1.f, 1.f}, gb = ga;
    if (kgain) { ga = *(const f32x4*)(kgain + k0 + 8 * c); gb = *(const f32x4*)(kgain + k0 + 8 * c + 4); }
#pragma unroll
    for (int j = 0; j < 4; ++j) { const int n = (lane >> 3) + 8 * j; const LAS float* s = scr + (8 * c) * 33 + n;
        v4u o; o.x = cvtpk(s[0 * 33] * ga[0], s[1 * 33] * ga[1]); o.y = cvtpk(s[2 * 33] * ga[2], s[3 * 33] * ga[3]); o.z = cvtpk(s[4 * 33] * gb[0], s[5 * 33] * gb[1]); o.w = cvtpk(s[6 * 33] * gb[2], s[7 * 33] * gb[3]);
        *(v4u*)(tiledN ? WT + ((size_t)(k0 >> 6) * tiledN + vrow0 + n) * 64 + 8 * c : WT + (size_t)(vrow0 + n) * K + k0 + 8 * c) = o; }
    LDS_WAIT(); asm volatile("" ::: "memory");
}
__device__ __forceinline__ int headperm_v(int w) { return 128 * ((w & 63) >> 5) + 32 * (w >> 6) + (w & 31); }
__device__ __forceinline__ int win_vrow(int n) {
    if (n < 2048) return (n & ~255) + headperm_v(n & 255);
    if (n < 6592) return n;
    return n + 64;
}
__device__ __forceinline__ void rms_row_to_bf16(const float* xrow, const float* gain, bf16* orow, int lane) {
    const f32x4* xr = (const f32x4*)xrow + lane; f32x4 v[8]; float s = 0.f;
#pragma unroll
    for (int j = 0; j < 8; ++j) { v[j] = xr[64 * j]; s += (v[j].x * v[j].x + v[j].y * v[j].y) + (v[j].z * v[j].z + v[j].w * v[j].w); }
    const float rs = __builtin_amdgcn_rsqf(wave_sum(s) * (1.0f / DM) + 1e-6f);
    u32x2* o8 = (u32x2*)orow + lane;
#pragma unroll
    for (int j = 0; j < 8; ++j) { const f32x4 g = *((const f32x4*)gain + lane + 64 * j); u32x2 w; w.x = cvtpk(v[j].x * rs * g.x, v[j].y * rs * g.y); w.y = cvtpk(v[j].z * rs * g.z, v[j].w * rs * g.w); o8[64 * j] = w; }
}
__device__ __forceinline__ void row_to_bf16_ss(const float* xrow, bf16* orow, float* ssp, int lane) {
    const f32x4* xr = (const f32x4*)xrow + lane; f32x4 v[8]; float s = 0.f;
#pragma unroll
    for (int j = 0; j < 8; ++j) { v[j] = xr[64 * j]; s += (v[j].x * v[j].x + v[j].y * v[j].y) + (v[j].z * v[j].z + v[j].w * v[j].w); }
    s = wave_sum(s); if (lane == 0) *ssp = s;
    u32x2* o8 = (u32x2*)orow + lane;
#pragma unroll
    for (int j = 0; j < 8; ++j) { u32x2 w; w.x = cvtpk(v[j].x, v[j].y); w.y = cvtpk(v[j].z, v[j].w); o8[64 * j] = w; }
}
__device__ __forceinline__ void p0_transpose_item32(const float* W, int K, int N, bf16* WT, int vrow0, int k0, int n0, LAS float* scr, int lane, const float* kgain) {
    float tv[16];
#pragma unroll
    for (int i = 0; i < 16; ++i) tv[i] = W[(size_t)(k0 + 2 * i + (lane >> 5)) * N + n0 + (lane & 31)];
#pragma unroll
    for (int i = 0; i < 16; ++i) scr[(2 * i + (lane >> 5)) * 33 + (lane & 31)] = tv[i];
    LDS_WAIT(); asm volatile("" ::: "memory");
    const int c = lane & 3; f32x4 ga = (f32x4){1.f, 1.f, 1.f, 1.f}, gb = ga;
    if (kgain) { ga = *(const f32x4*)(kgain + k0 + 8 * c); gb = *(const f32x4*)(kgain + k0 + 8 * c + 4); }
#pragma unroll
    for (int j = 0; j < 2; ++j) { const int n = (lane >> 2) + 16 * j; const LAS float* s = scr + (8 * c) * 33 + n;
        v4u o; o.x = cvtpk(s[0 * 33] * ga[0], s[1 * 33] * ga[1]); o.y = cvtpk(s[2 * 33] * ga[2], s[3 * 33] * ga[3]); o.z = cvtpk(s[4 * 33] * gb[0], s[5 * 33] * gb[1]); o.w = cvtpk(s[6 * 33] * gb[2], s[7 * 33] * gb[3]);
        *(v4u*)(WT + (size_t)(vrow0 + n) * K + k0 + 8 * c) = o; }
    LDS_WAIT(); asm volatile("" ::: "memory");
}
__device__ __forceinline__ void late_convert(const Params& p, LAS float* scr, int vw, int NVW, int lane) {
    unsigned char* ws = p.ws;
    constexpr int J_G = (DM / 32) * (DFF / 32), J_D = (DFF / 32) * (DM / 32), J_O = (SBW / 32) * (DM / 32), J_OUT = (DM / 32) * (DM / 32);
    constexpr int NJ = 2 * J_O + J_OUT + 2 * J_G + J_D;
    for (int it = vw; it < NJ; it += NVW) {
        int r = it;
        if (r < 2 * J_O) { const int which = r / J_O; r -= which * J_O; const int nblk = DM / 32, kb = r / nblk, nb = r % nblk;
            p0_transpose_item32(p.in[which ? 26 : 14], SBW, DM, (bf16*)(ws + (which ? WS_WRWO : WS_WSBO)), 32 * nb, 32 * kb, 32 * nb, scr, lane, nullptr); continue; }
        r -= 2 * J_O;
        if (r < J_OUT) { const int nblk = DM / 32, kb = r / nblk, nb = r % nblk; p0_transpose_item32(p.in[27], DM, DM, (bf16*)(ws + WS_WOUT), 32 * nb, 32 * kb, 32 * nb, scr, lane, nullptr); continue; }
        r -= J_OUT;
        if (r < 2 * J_G) { const int up = r / J_G; r -= up * J_G; const int nblk = DFF / 32, kb = r / nblk, nb = r % nblk, n0 = 32 * nb; const int vrow0 = 256 * (n0 >> 7) + (n0 & 127) + 128 * up;
            p0_transpose_item32(p.in[29 + up], DM, DFF, (bf16*)(ws + WS_W2GU), vrow0, 32 * kb, n0, scr, lane, p.in[28]); continue; }
        r -= 2 * J_G;
        { const int nblk = DM / 32, kb = r / nblk, nb = r % nblk; p0_transpose_item32(p.in[31], DFF, DM, (bf16*)(ws + WS_W2D), 32 * nb, 32 * kb, 32 * nb, scr, lane, nullptr); }
    }
}
__device__ __forceinline__ void conv_w1d(const Params& p, LAS float* scr, int vw, int NVW, int lane) {
    constexpr int I_D = (DFF / 64) * (DM / 32);
    for (int r = vw; r < I_D; r += NVW) { const int nblk = DM / 32, kb = r / nblk, nb = r % nblk; p0_transpose_item(p.in[9], DFF, DM, (bf16*)(p.ws + WS_W1D), 32 * nb, 64 * kb, 32 * nb, scr, lane); }
}
__device__ __forceinline__ void conv_win_lora(const Params& p, LAS float* scr, int vw, int NVW, int lane) {
    unsigned char* ws = p.ws;
    constexpr int I_IN = (DM / 64) * (10688 / 32);
    for (int r = vw; r < I_IN; r += NVW) { const int nblk = 10688 / 32, kb = r / nblk, nb = r % nblk, n0 = 32 * nb; p0_transpose_item(p.in[11], DM, 10688, (bf16*)(ws + WS_WIN), win_vrow(n0), 64 * kb, n0, scr, lane, p.in[10]); }
    { const int gt = vw * 64 + lane, NGT = NVW * 64; bf16* WT = (bf16*)(ws + WS_WIN) + (size_t)6592 * DM;
        for (int c = gt; c < 64 * DM / 8; c += NGT) *(v4u*)(WT + (size_t)c * 8) = (v4u){0u, 0u, 0u, 0u};
        bf16* WL = (bf16*)(ws + WS_WLORA);
        for (int c = gt; c < NLORA * (KLORA / 8); c += NGT) { const int vrow = c >> 6, kc = (c & 63) * 8; const int type = vrow >> 10, v = vrow & 255, tile = (vrow >> 8) & 3;
            const int ncol = tile * 256 + 64 * ((v >> 5) & 3) + 32 * (v >> 7) + (v & 31);
            const float* W = p.in[type == 0 ? 17 : (type == 1 ? 19 : 20)]; const int koff = type == 0 ? 0 : (type == 1 ? 128 : 256), kn = type == 2 ? 256 : 96;
            float f[8];
#pragma unroll
            for (int e = 0; e < 8; ++e) { const int k = kc + e - koff; f[e] = (k >= 0 && k < kn) ? W[(size_t)k * 1024 + ncol] : 0.f; }
            *(v4u*)(WL + (size_t)vrow * KLORA + kc) = (v4u){cvtpk(f[0], f[1]), cvtpk(f[2], f[3]), cvtpk(f[4], f[5]), cvtpk(f[6], f[7])}; } }
}
__device__ __forceinline__ void p0_prologue(const Params& p, LAS unsigned char* lds, int gw, int NGW, int wave, int lane) {
    LAS float* scr = (LAS float*)(lds + RING_OFF + wave * 16384);
    unsigned char* ws = p.ws;
    constexpr int I_G = (DM / 64) * (DFF / 32);
    for (int it = gw; it < 2 * I_G; it += NGW) { const int up = it / I_G, r = it - up * I_G;
        const int nblk = DFF / 32, kb = r / nblk, nb = r % nblk, n0 = 32 * nb; const int vrow0 = 256 * (n0 >> 7) + (n0 & 127) + 128 * up;
        p0_transpose_item(p.in[7 + up], DM, DFF, (bf16*)(ws + WS_W1GU), vrow0, 64 * kb, n0, scr, lane, p.in[6]); }
    for (int m = gw; m < M; m += NGW) { const float* xr = m < MPROMPT ? p.in[0] + (size_t)m * DM : p.in[1] + (size_t)(m - MPROMPT) * DM; row_to_bf16_ss(xr, (bf16*)(ws + WS_XN) + (size_t)m * DM, (float*)(ws + WS_CTL) + CW_SS0 + m, lane); }
    conv_win_lora(p, scr, gw, NGW, lane);
}
typedef pg8::StaticOrderT<M, DM, DFF, true> TailSO;
static_assert(TailSO::TAIL_UNITS == 64 && TailSO::SF == 4 && pg8::StaticOrderT<M, DM, DM, true>::TAIL_UNITS == 64 && pg8::StaticOrderT<M, DM, DM, true>::SF == 4, "tail geometry");
__device__ __forceinline__ void rms_row_tail(bf16* hrow, const float* xrow, float scale, const float* PART, int tpm, int tpn, int m, const float* gain, bf16* orow, int lane) {
    u32x2* hr = (u32x2*)hrow + lane; f32x4 v[8]; float s = 0.f; const int pm = m >> 8, rl = m & 255;
#pragma unroll
    for (int j = 0; j < 8; ++j) {
        const unsigned long long bal = __ballot(tpm == pm && tpn == j);
        if (bal) { const int uu = __builtin_ctzll(bal); const float* pp = PART + (size_t)uu * 4 * 65536 + rl * 256 + 4 * lane;
            f32x4 a; if (xrow) a = *((const f32x4*)xrow + lane + 64 * j); else { const u32x2 w = hr[64 * j]; a = (f32x4){bf_lo(w.x), bf_hi(w.x), bf_lo(w.y), bf_hi(w.y)}; }
            a += (*(const f32x4*)pp + *(const f32x4*)(pp + 65536) + *(const f32x4*)(pp + 2 * 65536) + *(const f32x4*)(pp + 3 * 65536)) * scale;
            u32x2 w; w.x = cvtpk(a[0], a[1]); w.y = cvtpk(a[2], a[3]); hr[64 * j] = w; v[j] = (f32x4){bf_lo(w.x), bf_hi(w.x), bf_lo(w.y), bf_hi(w.y)}; }
        else { const u32x2 w = hr[64 * j]; v[j] = (f32x4){bf_lo(w.x), bf_hi(w.x), bf_lo(w.y), bf_hi(w.y)}; }
        s += (v[j].x * v[j].x + v[j].y * v[j].y) + (v[j].z * v[j].z + v[j].w * v[j].w); }
    const float rs = __builtin_amdgcn_rsqf(wave_sum(s) * (1.0f / DM) + 1e-6f);
    u32x2* o8 = (u32x2*)orow + lane;
#pragma unroll
    for (int j = 0; j < 8; ++j) { const f32x4 g = *((const f32x4*)gain + lane + 64 * j); u32x2 w; w.x = cvtpk(v[j].x * rs * g.x, v[j].y * rs * g.y); w.y = cvtpk(v[j].z * rs * g.z, v[j].w * rs * g.w); o8[64 * j] = w; }
}
__device__ __forceinline__ void norm_phase(bf16* H, const float* xb0, const float* xb1, float scale, const float* PART, const float* gain, bf16* XN, int gw, int NGW, int lane) {
    const int t = pg8::tile_of(TailSO::full * pg8::GRID + lane, TailSO::nM, TailSO::nN), tpm = t & 0xffff, tpn = t >> 16;
    for (int m = gw; m < M; m += NGW) { bf16* hrow = H + (size_t)m * DM; const float* xrow = xb0 ? (m < MPROMPT ? xb0 : xb1) + (size_t)m * DM : nullptr;
        rms_row_tail(hrow, xrow, scale, PART, tpm, tpn, m, gain, XN + (size_t)m * DM, lane); }
}
__device__ __forceinline__ f32x4 part4(const bf16* pp) {
    f32x4 s = (f32x4){0.f, 0.f, 0.f, 0.f};
#pragma unroll
    for (int q = 0; q < 4; ++q) { const u32x2 w = *(const u32x2*)(pp + (size_t)q * 65536); s += (f32x4){bf_lo(w.x), bf_hi(w.x), bf_lo(w.y), bf_hi(w.y)}; }
    return s;
}
__device__ __forceinline__ void tail_combine_h(const bf16* base, float scale, const float* PART, bf16* H, float* ss, int gw, int NGW, int lane) {
    for (int pc = gw; pc < TailSO::TAIL_UNITS * 256; pc += NGW) { const int uu = pc >> 8, rl = pc & 255; const int t = pg8::tile_of(TailSO::full * pg8::GRID + uu, TailSO::nM, TailSO::nN), pm = t & 0xffff, pn = t >> 16;
        const size_t off = (size_t)(pm * 256 + rl) * DM + pn * 256 + 4 * lane; const bf16* pp = (const bf16*)PART + (size_t)uu * 4 * 65536 + rl * 256 + 4 * lane;
        const u32x2 w = *(const u32x2*)(base + off); const f32x4 b = (f32x4){bf_lo(w.x), bf_hi(w.x), bf_lo(w.y), bf_hi(w.y)};
        const f32x4 v = b + part4(pp) * scale;
        u32x2 o; o.x = cvtpk(v[0], v[1]); o.y = cvtpk(v[2], v[3]); *(u32x2*)(H + off) = o;
        const float sq = wave_sum((v[0] * v[0] + v[1] * v[1]) + (v[2] * v[2] + v[3] * v[3]));
        if (lane == 0) unsafeAtomicAdd(ss + pm * 256 + rl, sq); }
}
__device__ __forceinline__ void tail_combine(const bf16* H, float scale, const float* PART, float* out, int gw, int NGW, int lane) {
    for (int pc = gw; pc < TailSO::TAIL_UNITS * 256; pc += NGW) { const int uu = pc >> 8, rl = pc & 255; const int t = pg8::tile_of(TailSO::full * pg8::GRID + uu, TailSO::nM, TailSO::nN), pm = t & 0xffff, pn = t >> 16;
        const size_t off = (size_t)(pm * 256 + rl) * DM + pn * 256 + 4 * lane; const bf16* pp = (const bf16*)PART + (size_t)uu * 4 * 65536 + rl * 256 + 4 * lane;
        const u32x2 w = *(const u32x2*)(H + off); const f32x4 h = (f32x4){bf_lo(w.x), bf_hi(w.x), bf_lo(w.y), bf_hi(w.y)};
        *(f32x4*)(out + off) = h + part4(pp) * scale; }
}
constexpr int VT_PITCH = 36;
constexpr int VT_BYTES = 64 * VT_PITCH * 2;
#if MSCAN
constexpr int ATT_WAVE_STRIDE = VT_BYTES;
#else
constexpr int ATT_WAVE_STRIDE = 16384;
#endif
constexpr int N_ATT_UNITS = NBP * 16 * (TP / 32) + NBS * 16 * (TS / 32);
__device__ __forceinline__ int crow(int r, int hi) { return (r & 3) + 8 * (r >> 2) + 4 * hi; }
__device__ __forceinline__ void attn_unit(const Params& p, int unit, LAS unsigned char* vtb, int lane, const bf16x8 (&mtri)[2]) {
    const int r32 = lane & 31, hi = lane >> 5;
    int h, qb, P; size_t row0; const float *kn, *vn, *kc = nullptr, *vc = nullptr;
    if (unit < NBP * 16 * (TP / 32)) { const int b = unit >> 12; h = (unit >> 8) & 15; qb = unit & 255; P = 0; row0 = (size_t)b * TP; kn = p.out + O_KP + row0 * SBW; vn = p.out + O_VP + row0 * SBW; }
    else { const int u2 = unit - NBP * 16 * (TP / 32); const int s = u2 >> 5; h = (u2 >> 1) & 15; qb = u2 & 1; P = PAST; row0 = (size_t)MPROMPT + (size_t)s * TS;
        kn = p.out + O_KS + (size_t)s * TS * SBW; vn = p.out + O_VS + (size_t)s * TS * SBW; kc = p.in[2] + (size_t)s * PAST * SBW; vc = p.in[3] + (size_t)s * PAST * SBW; }
    const bf16* Qb = (const bf16*)(p.ws + WS_QB) + (row0 + (size_t)qb * 32 + r32) * SBW + h * 64 + hi * 8;
    bf16x8 qf[4];
#pragma unroll
    for (int d0 = 0; d0 < 4; ++d0) qf[d0] = *(const bf16x8*)(Qb + 16 * d0);
    f32x16 o0 = {}, o1 = {}; float carry = 0.f;
    LAS unsigned short* vt = (LAS unsigned short*)vtb;
    const int nq = P + qb * 32;
    for (int n0 = nq; n0 >= 0; n0 -= 32) {
        const float* kb = (n0 >= P ? kn + (size_t)(n0 - P) * SBW : kc + (size_t)n0 * SBW) + h * 64;
        const float* vb = (n0 >= P ? vn + (size_t)(n0 - P) * SBW : vc + (size_t)n0 * SBW) + h * 64;
        f32x4 vr[8];
#pragma unroll
        for (int i = 0; i < 8; ++i) vr[i] = *(const f32x4*)(vb + (size_t)((lane >> 4) + 4 * i) * SBW + 4 * (lane & 15));
        f32x16 s = {};
#pragma unroll
        for (int d0 = 0; d0 < 4; ++d0) { const float* kp = kb + (size_t)r32 * SBW + 16 * d0 + 8 * hi; const f32x4 a = *(const f32x4*)kp, b = *(const f32x4*)(kp + 4);
            const v4u w = (v4u){cvtpk(a[0], a[1]), cvtpk(a[2], a[3]), cvtpk(b[0], b[1]), cvtpk(b[2], b[3])};
            s = __builtin_amdgcn_mfma_f32_32x32x16_bf16(__builtin_bit_cast(bf16x8, w), qf[d0], s, 0, 0, 0); }
#pragma unroll
        for (int i = 0; i < 8; ++i) { const int key = (lane >> 4) + 4 * i, d = 4 * (lane & 15); const unsigned w0 = cvtpk(vr[i][0], vr[i][1]), w1 = cvtpk(vr[i][2], vr[i][3]);
            vt[(d + 0) * VT_PITCH + key] = (unsigned short)(w0 & 0xffffu); vt[(d + 1) * VT_PITCH + key] = (unsigned short)(w0 >> 16);
            vt[(d + 2) * VT_PITCH + key] = (unsigned short)(w1 & 0xffffu); vt[(d + 3) * VT_PITCH + key] = (unsigned short)(w1 >> 16); }
        asm volatile("" ::: "memory");
        const bool diag = (n0 == nq);
        float lk[16], lb[16]; float lsum = 0.f;
#pragma unroll
        for (int r = 0; r < 16; ++r) { const float z = s[r]; const float sp = fmaxf(z, 0.f) + __logf(1.0f + __expf(-fabsf(z)));
            const bool valid = !diag || (crow(r, hi) < r32);
            lk[r] = valid ? -sp : 0.f; lb[r] = valid ? (z - sp) : -INFINITY; lsum += lk[r]; }
        f32x16 tl = {};
#pragma unroll
        for (int kk = 0; kk < 2; ++kk) { v4u wh, wl;
#pragma unroll
            for (int e = 0; e < 4; ++e) { const float x0 = lk[8 * kk + 2 * e], x1 = lk[8 * kk + 2 * e + 1]; const unsigned w = cvtpk(x0, x1); wh[e] = w; wl[e] = cvtpk(x0 - bf_lo(w), x1 - bf_hi(w)); }
            tl = __builtin_amdgcn_mfma_f32_32x32x16_bf16(mtri[kk], __builtin_bit_cast(bf16x8, wh), tl, 0, 0, 0);
            tl = __builtin_amdgcn_mfma_f32_32x32x16_bf16(mtri[kk], __builtin_bit_cast(bf16x8, wl), tl, 0, 0, 0); }
        v4u wk[2];
#pragma unroll
        for (int kk = 0; kk < 2; ++kk)
#pragma unroll
            for (int e = 0; e < 4; ++e) { const int r = 8 * kk + 2 * e; wk[kk][e] = cvtpk(__expf(lb[r] + carry + tl[r]), __expf(lb[r + 1] + carry + tl[r + 1])); }
#pragma unroll
        for (int kk = 0; kk < 2; ++kk) {
            const LAS unsigned short* a0p = vt + r32 * VT_PITCH + 16 * kk + 4 * hi; const LAS unsigned short* a1p = a0p + 32 * VT_PITCH;
            const u32x2 x0 = *(const LAS u32x2*)a0p, x1 = *(const LAS u32x2*)(a0p + 8), y0 = *(const LAS u32x2*)a1p, y1 = *(const LAS u32x2*)(a1p + 8);
            o0 = __builtin_amdgcn_mfma_f32_32x32x16_bf16(__builtin_bit_cast(bf16x8, (v4u){x0.x, x0.y, x1.x, x1.y}), __builtin_bit_cast(bf16x8, wk[kk]), o0, 0, 0, 0);
            o1 = __builtin_amdgcn_mfma_f32_32x32x16_bf16(__builtin_bit_cast(bf16x8, (v4u){y0.x, y0.y, y1.x, y1.y}), __builtin_bit_cast(bf16x8, wk[kk]), o1, 0, 0, 0); }
        asm volatile("" ::: "memory");
        lsum = xsum32(lsum); carry += lsum;
        if (__all(carry < -104.0f)) break;
    }
    bf16* O = (bf16*)(p.ws + WS_AO) + (row0 + (size_t)qb * 32 + r32) * SBW + h * 64 + 4 * hi;
#pragma unroll
    for (int g = 0; g < 4; ++g) { u32x2 a, b; a.x = cvtpk(o0[4 * g], o0[4 * g + 1]); a.y = cvtpk(o0[4 * g + 2], o0[4 * g + 3]); b.x = cvtpk(o1[4 * g], o1[4 * g + 1]); b.y = cvtpk(o1[4 * g + 2], o1[4 * g + 3]);
        *(u32x2*)(O + 8 * g) = a; *(u32x2*)(O + 32 + 8 * g) = b; }
}
constexpr int ATT_N1 = ATT_SPLIT1, ATT_N2 = ATT_SPLIT2;
__device__ __forceinline__ void attn_phase(const Params& p, LAS unsigned char* vt, unsigned* queue, int ubase, int ucount, int lane) {
    bf16x8 mtri[2]; const int r32 = lane & 31, hi = lane >> 5;
#pragma unroll
    for (int kk = 0; kk < 2; ++kk)
#pragma unroll
        for (int e = 0; e < 8; ++e) mtri[kk][e] = (crow(8 * kk + e, hi) > r32) ? (short)0x3F80 : (short)0;
    for (;;) {
        unsigned u = 0; if (lane == 0) u = __hip_atomic_fetch_add(queue, 1u, __ATOMIC_RELAXED, __HIP_MEMORY_SCOPE_AGENT);
        u = (unsigned)__builtin_amdgcn_readfirstlane((int)u);
        if (u >= (unsigned)ucount) break;
        attn_unit(p, ubase + (int)u, vt, lane, mtri);
    }
}
__device__ __forceinline__ void shift_phase(const Params& p, int gw, int NGW, int lane) {
    const bf16* PRW = (const bf16*)(p.ws + WS_PRW); const float* mu = p.in[15]; bf16* ACAT = (bf16*)(p.ws + WS_ACAT);
    for (int m = gw; m < M; m += NGW) {
        const bool prompt = m < MPROMPT; const int t = prompt ? (m & (TP - 1)) : ((m - MPROMPT) & (TS - 1)); const bool first = (t == 0);
        if (lane < 56) { const int col = 3072 + lane * 8;
            const v4u pw = *(const v4u*)(PRW + (size_t)m * RWCP + col); float pv[8], qv[8];
            pv[0] = bf_lo(pw.x); pv[1] = bf_hi(pw.x); pv[2] = bf_lo(pw.y); pv[3] = bf_hi(pw.y); pv[4] = bf_lo(pw.z); pv[5] = bf_hi(pw.z); pv[6] = bf_lo(pw.w); pv[7] = bf_hi(pw.w);
            if (!first) { const v4u qw = *(const v4u*)(PRW + (size_t)(m - 1) * RWCP + col);
                qv[0] = bf_lo(qw.x); qv[1] = bf_hi(qw.x); qv[2] = bf_lo(qw.y); qv[3] = bf_hi(qw.y); qv[4] = bf_lo(qw.z); qv[5] = bf_hi(qw.z); qv[6] = bf_lo(qw.w); qv[7] = bf_hi(qw.w); }
            else if (prompt) {
#pragma unroll
                for (int e = 0; e < 8; ++e) qv[e] = 0.f; }
            else { const float* sh0 = p.in[5] + (size_t)((m - MPROMPT) >> 6) * RWC; const f32x4 a = *(const f32x4*)(sh0 + col), b = *(const f32x4*)(sh0 + col + 4);
                qv[0] = a[0]; qv[1] = a[1]; qv[2] = a[2]; qv[3] = a[3]; qv[4] = b[0]; qv[5] = b[1]; qv[6] = b[2]; qv[7] = b[3]; }
            const f32x4 m0 = *(const f32x4*)(mu + col), m1 = *(const f32x4*)(mu + col + 4); float x[8];
#pragma unroll
            for (int e2 = 0; e2 < 8; ++e2) x[e2] = pv[e2] + (qv[e2] - pv[e2]) * (e2 < 4 ? m0[e2] : m1[e2 - 4]);
            bf16* dst;
            if (col < 3168) { dst = ACAT + (size_t)m * KLORA + (col - 3072);
#pragma unroll
                for (int e2 = 0; e2 < 8; ++e2) x[e2] = tanhf(x[e2]); }
            else if (col < 3264) dst = ACAT + (size_t)m * KLORA + 128 + (col - 3168);
            else { dst = ACAT + (size_t)m * KLORA + 256 + (col - 3264);
#pragma unroll
                for (int e2 = 0; e2 < 8; ++e2) x[e2] = pg8::sigm(x[e2]); }
            *(v4u*)dst = (v4u){cvtpk(x[0], x[1]), cvtpk(x[2], x[3]), cvtpk(x[4], x[5]), cvtpk(x[6], x[7])};
        } else *(v4u*)(ACAT + (size_t)m * KLORA + (lane < 60 ? 96 + 8 * (lane - 56) : 224 + 8 * (lane - 60))) = (v4u){0u, 0u, 0u, 0u};
    }
}
typedef float f2 __attribute__((ext_vector_type(2)));
constexpr int SC_BLK = 8, SC_ARR = 1024, SC_W = 6 * SC_ARR, SC_BUF = SC_W + 2 * SC_ARR, SC_WAVE = 2 * SC_BUF;
static_assert(NWAVES * SC_WAVE <= RING_BYTES && CH % SC_BLK == 0 && TS % SC_BLK == 0, "scan staging");
__device__ __forceinline__ void cvt8(const v4u q, float (&f)[8]) { f[0] = bf_lo(q.x); f[1] = bf_hi(q.x); f[2] = bf_lo(q.y); f[3] = bf_hi(q.y); f[4] = bf_lo(q.z); f[5] = bf_hi(q.z); f[6] = bf_lo(q.w); f[7] = bf_hi(q.w); }
__device__ __forceinline__ void cvt8p(const v4u q, f2 (&f)[4]) { f[0] = (f2){bf_lo(q.x), bf_hi(q.x)}; f[1] = (f2){bf_lo(q.y), bf_hi(q.y)}; f[2] = (f2){bf_lo(q.z), bf_hi(q.z)}; f[3] = (f2){bf_lo(q.w), bf_hi(q.w)}; }
template <bool WITH_Y> __device__ __forceinline__ void stage_issue(const unsigned char* ws, size_t mblk, int h, int lane, LAS unsigned char* buf) {
    const size_t o = (mblk + (lane >> 3)) * RWW + h * 64 + (lane & 7) * 8;
    __builtin_amdgcn_global_load_lds((const unsigned*)((const bf16*)(ws + WS_KKN) + o), (LAS unsigned*)(buf + 0 * SC_ARR), 16, 0, 0);
    __builtin_amdgcn_global_load_lds((const unsigned*)((const bf16*)(ws + WS_BV) + o), (LAS unsigned*)(buf + 1 * SC_ARR), 16, 0, 0);
    __builtin_amdgcn_global_load_lds((const unsigned*)((const bf16*)(ws + WS_KP) + o), (LAS unsigned*)(buf + 2 * SC_ARR), 16, 0, 0);
    __builtin_amdgcn_global_load_lds((const unsigned*)((const bf16*)(ws + WS_XV) + o), (LAS unsigned*)(buf + 3 * SC_ARR), 16, 0, 0);
    if (WITH_Y) { __builtin_amdgcn_global_load_lds((const unsigned*)((const bf16*)(ws + WS_XR) + o), (LAS unsigned*)(buf + 4 * SC_ARR), 16, 0, 0);
                  __builtin_amdgcn_global_load_lds((const unsigned*)((const bf16*)(ws + WS_G) + o), (LAS unsigned*)(buf + 5 * SC_ARR), 16, 0, 0); }
    const float* wp = (const float*)(ws + WS_WD) + (mblk + (lane >> 4)) * RWW + h * 64 + (lane & 15) * 4;
    __builtin_amdgcn_global_load_lds((const unsigned*)wp, (LAS unsigned*)(buf + SC_W), 16, 0, 0);
    __builtin_amdgcn_global_load_lds((const unsigned*)(wp + 4 * RWW), (LAS unsigned*)(buf + SC_W + SC_ARR), 16, 0, 0);
}
#define STAGE_LANDED() asm volatile("s_waitcnt vmcnt(0)" ::: "memory")
#define SCAN_DOT(X, V2, OUT) do { _Pragma("unroll") for (int a = 0; a < 8; ++a) { f2 s_ = X[a][0] * V2[0]; _Pragma("unroll") for (int c = 1; c < 4; ++c) s_ = X[a][c] * V2[c] + s_; OUT[a] = red8(s_.x + s_.y); } } while (0)

__device__ __forceinline__ void scan_pass_a(const Params& p, int unit, LAS unsigned char* wbuf, int lane) {
    const int bh = unit / NCH, c = unit % NCH, b = bh >> 4, h = bh & 15, li = lane >> 3, lj = lane & 7;
    const size_t m0 = (size_t)b * TP + (size_t)c * CH;
    f2 U[8][4], Pm[8][4];
#pragma unroll
    for (int a = 0; a < 8; ++a)
#pragma unroll
        for (int cc = 0; cc < 4; ++cc) { U[a][cc] = (f2){0.f, 0.f}; Pm[a][cc] = (f2){(8 * li + a == 8 * lj + 2 * cc) ? 1.f : 0.f, (8 * li + a == 8 * lj + 2 * cc + 1) ? 1.f : 0.f}; }
    stage_issue<false>(p.ws, m0, h, lane, wbuf);
    STAGE_LANDED();
#pragma unroll 1
    for (int k = 0; k < CH / SC_BLK; ++k) {
        LAS unsigned char* cur = wbuf + (k & 1) * SC_BUF;
        if (k + 1 < CH / SC_BLK) stage_issue<false>(p.ws, m0 + (size_t)(k + 1) * SC_BLK, h, lane, wbuf + ((k + 1) & 1) * SC_BUF);
#pragma unroll 1
        for (int t = 0; t < SC_BLK; ++t) {
            f2 kn[4], bb[4], kp[4], w[4]; float v[8];
            cvt8p(*(const LAS v4u*)(cur + 0 * SC_ARR + t * 128 + lj * 16), kn); cvt8p(*(const LAS v4u*)(cur + 1 * SC_ARR + t * 128 + lj * 16), bb); cvt8p(*(const LAS v4u*)(cur + 2 * SC_ARR + t * 128 + lj * 16), kp);
            cvt8(*(const LAS v4u*)(cur + 3 * SC_ARR + t * 128 + li * 16), v);
            { const f32x4 w0 = *(const LAS f32x4*)(cur + SC_W + t * 256 + lj * 32), w1 = *(const LAS f32x4*)(cur + SC_W + t * 256 + lj * 32 + 16);
              w[0] = (f2){w0[0], w0[1]}; w[1] = (f2){w0[2], w0[3]}; w[2] = (f2){w1[0], w1[1]}; w[3] = (f2){w1[2], w1[3]}; }
            float du[8], dp[8];
            SCAN_DOT(U, kn, du); SCAN_DOT(Pm, kn, dp);
#pragma unroll
            for (int a = 0; a < 8; ++a)
#pragma unroll
                for (int cc = 0; cc < 4; ++cc) { U[a][cc] = U[a][cc] * w[cc] + (kp[cc] * v[a] - bb[cc] * du[a]); Pm[a][cc] = Pm[a][cc] * w[cc] - bb[cc] * dp[a]; }
        }
        STAGE_LANDED();
    }
    float* Uo = (float*)(p.ws + WS_UC) + (size_t)unit * 4096; float* Po = (float*)(p.ws + WS_PC) + (size_t)unit * 4096;
#pragma unroll
    for (int a = 0; a < 8; ++a) { float* up = Uo + (8 * li + a) * 64 + 8 * lj; *(f32x4*)up = (f32x4){U[a][0].x, U[a][0].y, U[a][1].x, U[a][1].y}; *(f32x4*)(up + 4) = (f32x4){U[a][2].x, U[a][2].y, U[a][3].x, U[a][3].y}; }
#pragma unroll
    for (int cc = 0; cc < 8; ++cc)
#pragma unroll
        for (int ah = 0; ah < 2; ++ah) { const int jb = li >> 1, kq = (2 * li + ah) & 3, jpb = lj >> 1, jpl = 8 * (lj & 1) + cc;
            *(f32x4*)(Po + (((jpb * 4 + jb) * 64 + kq * 16 + jpl) * 4)) = (f32x4){Pm[4 * ah][cc >> 1][cc & 1], Pm[4 * ah + 1][cc >> 1][cc & 1], Pm[4 * ah + 2][cc >> 1][cc & 1], Pm[4 * ah + 3][cc >> 1][cc & 1]}; }
}
__device__ __forceinline__ void scan_pass_c(const Params& p, size_t m0, int h, int nsteps, const float* S0, float* Sfin, LAS unsigned char* wbuf, int lane) {
    const int li = lane >> 3, lj = lane & 7; const int cj = h * 64 + 8 * lj, ci = h * 64 + 8 * li;
    f2 S[8][4];
#pragma unroll
    for (int a = 0; a < 8; ++a) { const float* sp = S0 + (8 * li + a) * 64 + 8 * lj; const f32x4 x0 = *(const f32x4*)sp, x1 = *(const f32x4*)(sp + 4);
        S[a][0] = (f2){x0[0], x0[1]}; S[a][1] = (f2){x0[2], x0[3]}; S[a][2] = (f2){x1[0], x1[1]}; S[a][3] = (f2){x1[2], x1[3]}; }
    float lnw[8], lnb[8]; f2 rk[4];
    { const f32x4 a0 = *(const f32x4*)(p.in[24] + ci), a1 = *(const f32x4*)(p.in[24] + ci + 4), b0 = *(const f32x4*)(p.in[25] + ci), b1 = *(const f32x4*)(p.in[25] + ci + 4), c0 = *(const f32x4*)(p.in[23] + cj), c1 = *(const f32x4*)(p.in[23] + cj + 4);
#pragma unroll
        for (int e = 0; e < 4; ++e) { lnw[e] = a0[e]; lnw[4 + e] = a1[e]; lnb[e] = b0[e]; lnb[4 + e] = b1[e]; }
        rk[0] = (f2){c0[0], c0[1]}; rk[1] = (f2){c0[2], c0[3]}; rk[2] = (f2){c1[0], c1[1]}; rk[3] = (f2){c1[2], c1[3]}; }
    bf16* Y = (bf16*)(p.ws + WS_YRW);
    const int nblk = nsteps / SC_BLK;
    stage_issue<true>(p.ws, m0, h, lane, wbuf);
    STAGE_LANDED();
#pragma unroll 1
    for (int k = 0; k < nblk; ++k) {
        LAS unsigned char* cur = wbuf + (k & 1) * SC_BUF;
        if (k + 1 < nblk) stage_issue<true>(p.ws, m0 + (size_t)(k + 1) * SC_BLK, h, lane, wbuf + ((k + 1) & 1) * SC_BUF);
#pragma unroll 1
        for (int t = 0; t < SC_BLK; ++t) {
            f2 kn[4], bb[4], kp[4], w[4], r[4]; float v[8], g[8];
            cvt8p(*(const LAS v4u*)(cur + 0 * SC_ARR + t * 128 + lj * 16), kn); cvt8p(*(const LAS v4u*)(cur + 1 * SC_ARR + t * 128 + lj * 16), bb); cvt8p(*(const LAS v4u*)(cur + 2 * SC_ARR + t * 128 + lj * 16), kp);
            cvt8(*(const LAS v4u*)(cur + 3 * SC_ARR + t * 128 + li * 16), v); cvt8p(*(const LAS v4u*)(cur + 4 * SC_ARR + t * 128 + lj * 16), r); cvt8(*(const LAS v4u*)(cur + 5 * SC_ARR + t * 128 + li * 16), g);
            { const f32x4 w0 = *(const LAS f32x4*)(cur + SC_W + t * 256 + lj * 32), w1 = *(const LAS f32x4*)(cur + SC_W + t * 256 + lj * 32 + 16);
              w[0] = (f2){w0[0], w0[1]}; w[1] = (f2){w0[2], w0[3]}; w[2] = (f2){w1[0], w1[1]}; w[3] = (f2){w1[2], w1[3]}; }
            float ds[8], y[8];
            SCAN_DOT(S, kn, ds);
#pragma unroll
            for (int a = 0; a < 8; ++a)
#pragma unroll
                for (int cc = 0; cc < 4; ++cc) S[a][cc] = S[a][cc] * w[cc] + (kp[cc] * v[a] - bb[cc] * ds[a]);
            SCAN_DOT(S, r, y);
            f2 rk2 = r[0] * kp[0] * rk[0];
#pragma unroll
            for (int cc = 1; cc < 4; ++cc) rk2 = r[cc] * kp[cc] * rk[cc] + rk2;
            const float rkk = red8(rk2.x + rk2.y);
            float s1 = 0.f, s2 = 0.f;
#pragma unroll
            for (int a = 0; a < 8; ++a) { s1 += y[a]; s2 += y[a] * y[a]; }
            s1 = red_hi8(s1); s2 = red_hi8(s2);
            const float mean = s1 * (1.0f / 64.0f); const float var = fmaxf(s2 * (1.0f / 64.0f) - mean * mean, 0.f);
            const float rstd = __builtin_amdgcn_rsqf(var + 64e-5f);
            float o[8];
#pragma unroll
            for (int a = 0; a < 8; ++a) o[a] = (((y[a] - mean) * rstd) * lnw[a] + lnb[a] + rkk * v[a]) * g[a];
            if (lj == 0) *(v4u*)(Y + (m0 + (size_t)k * SC_BLK + t) * RWW + ci) = (v4u){cvtpk(o[0], o[1]), cvtpk(o[2], o[3]), cvtpk(o[4], o[5]), cvtpk(o[6], o[7])};
        }
        STAGE_LANDED();
    }
    if (Sfin) {
#pragma unroll
        for (int a = 0; a < 8; ++a) { float* sp = Sfin + (8 * li + a) * 64 + 8 * lj; *(f32x4*)sp = (f32x4){S[a][0].x, S[a][0].y, S[a][1].x, S[a][1].y}; *(f32x4*)(sp + 4) = (f32x4){S[a][2].x, S[a][2].y, S[a][3].x, S[a][3].y}; }
    }
}
__device__ __forceinline__ void scan_pass_b(const Params& p, int unit, int lane) {
    const int bh = unit >> 2, ib = unit & 3, i = lane & 15, q4 = lane >> 4;
    const float* Pc = (const float*)(p.ws + WS_PC) + (size_t)bh * NCH * 4096; const float* Uc = (const float*)(p.ws + WS_UC) + (size_t)bh * NCH * 4096; float* Sc = (float*)(p.ws + WS_SC) + (size_t)bh * NCH * 4096;
    const int roff = (16 * ib + i) * 64 + 4 * q4;
    f32x4 S[4];
#pragma unroll
    for (int jb = 0; jb < 4; ++jb) S[jb] = (f32x4){0.f, 0.f, 0.f, 0.f};
    f32x4 pa[4][4], un[4];
#pragma unroll
    for (int x = 0; x < 4; ++x) { un[x] = *(const f32x4*)(Uc + roff + 16 * x);
#pragma unroll
        for (int jb = 0; jb < 4; ++jb) pa[x][jb] = *(const f32x4*)(Pc + ((x * 4 + jb) * 64 + lane) * 4); }
#pragma unroll 1
    for (int c = 0; c < NCH; ++c) {
#pragma unroll
        for (int jb = 0; jb < 4; ++jb) *(f32x4*)(Sc + (size_t)c * 4096 + roff + 16 * jb) = S[jb];
        f32x4 pc[4][4], acc[4];
#pragma unroll
        for (int x = 0; x < 4; ++x) { acc[x] = un[x];
#pragma unroll
            for (int jb = 0; jb < 4; ++jb) pc[x][jb] = pa[x][jb]; }
        if (c + 1 < NCH) {
#pragma unroll
            for (int x = 0; x < 4; ++x) { un[x] = *(const f32x4*)(Uc + (size_t)(c + 1) * 4096 + roff + 16 * x);
#pragma unroll
                for (int jb = 0; jb < 4; ++jb) pa[x][jb] = *(const f32x4*)(Pc + (size_t)(c + 1) * 4096 + ((x * 4 + jb) * 64 + lane) * 4); } }
#pragma unroll
        for (int x = 0; x < 4; ++x)
#pragma unroll
            for (int jb = 0; jb < 4; ++jb)
#pragma unroll
                for (int e = 0; e < 4; ++e) acc[x] = __builtin_amdgcn_mfma_f32_16x16x4f32(pc[x][jb][e], S[jb][e], acc[x], 0, 0, 0);
#pragma unroll
        for (int x = 0; x < 4; ++x) S[x] = acc[x];
    }
    float* Sf = p.out + O_WKVP + (size_t)bh * 4096;
#pragma unroll
    for (int jb = 0; jb < 4; ++jb) *(f32x4*)(Sf + roff + 16 * jb) = S[jb];
}
namespace ms {
constexpr int SB = 16;
constexpr int RAW_W = 0, RAW_KN = 2048, RAW_BV = 4096, RAW_KP = 6144, RAW_XR = 8192, RAW_XV = 10240, RAW_BYTES = 14336;
constexpr int XA_PB = 144, XT_PB = 80;
constexpr int D_XA = RAW_BYTES;
constexpr int D_XB = D_XA + 32 * XA_PB;
constexpr int SV_PB = 64;
constexpr int D_SVT = D_XB;
constexpr int D_RH = D_XA;
constexpr int D_XBT = D_XA + 9216;
constexpr int D_MBF = D_XBT + 64 * XT_PB;
constexpr int D_ARHS = D_MBF + 1024;
constexpr int D_RA = D_ARHS + 16 * XT_PB;
constexpr int D_GAM = D_RA + 16 * XT_PB;
constexpr int D_RKK = D_GAM + 256;
constexpr int WAVE_BYTES = 32768;
static_assert(D_XB + 32 * XA_PB == D_XBT && D_RH + 4096 <= D_XB && D_SVT + 64 * SV_PB <= D_XBT && D_RKK + 64 <= WAVE_BYTES && 4 * WAVE_BYTES <= RING_BYTES, "mscan LDS map");
typedef float f4 __attribute__((ext_vector_type(4)));
__device__ __forceinline__ f4 mfma16(const bf16x8 a, const bf16x8 b, const f4 c) { return __builtin_amdgcn_mfma_f32_16x16x32_bf16(a, b, c, 0, 0, 0); }
__device__ __forceinline__ float bfu(unsigned short u) { return __uint_as_float((unsigned)u << 16); }
__device__ __forceinline__ bf16x8 pack_f8(const f4 a, const f4 b) { const v4u w = (v4u){cvtpk(a[0], a[1]), cvtpk(a[2], a[3]), cvtpk(b[0], b[1]), cvtpk(b[2], b[3])}; return __builtin_bit_cast(bf16x8, w); }
__device__ __forceinline__ void raw_issue(const unsigned char* ws, size_t mblk, int h, int lane, LAS unsigned char* raw) {
    ws = *(const unsigned char* const __attribute__((address_space(4)))*)((const __attribute__((address_space(4))) char*)__builtin_amdgcn_kernarg_segment_ptr() + __builtin_offsetof(Params, ws));
    const size_t ub = (mblk * RWW + (size_t)h * 64);
    unsigned lb = (unsigned)(((lane >> 3) * RWW + (lane & 7) * 8) * 2);
    unsigned lp = (unsigned)(((lane >> 3) * RWCP + (lane & 7) * 8) * 2);
    asm volatile("" : "+v"(lb), "+v"(lp));
    const unsigned char* b0 = ws + WS_KKN + ub * 2; const unsigned char* b1 = ws + WS_BV + ub * 2; const unsigned char* b2 = ws + WS_KP + ub * 2; const unsigned char* b3 = ws + WS_PRW + (mblk * RWCP + (size_t)h * 64) * 2; const unsigned char* b4 = b3 + 2048 * 2; const unsigned char* b5 = ws + WS_WD + ub * 2;
#pragma unroll
    for (int i = 0; i < 2; ++i) { const size_t oo = (size_t)i * 8 * RWW * 2;
        __builtin_amdgcn_global_load_lds((const unsigned*)(b5 + lb + oo), (LAS unsigned*)(raw + RAW_W + i * 1024), 16, 0, 0);
        __builtin_amdgcn_global_load_lds((const unsigned*)(b0 + lb + oo), (LAS unsigned*)(raw + RAW_KN + i * 1024), 16, 0, 0);
        __builtin_amdgcn_global_load_lds((const unsigned*)(b1 + lb + oo), (LAS unsigned*)(raw + RAW_BV + i * 1024), 16, 0, 0); asm volatile("" ::: "memory");
        __builtin_amdgcn_global_load_lds((const unsigned*)(b2 + lb + oo), (LAS unsigned*)(raw + RAW_KP + i * 1024), 16, 0, 0);
        __builtin_amdgcn_global_load_lds((const unsigned*)(b3 + lp + (size_t)i * 8 * RWCP * 2), (LAS unsigned*)(raw + RAW_XR + i * 1024), 16, 0, 0);
        __builtin_amdgcn_global_load_lds((const unsigned*)(b4 + lp + (size_t)i * 8 * RWCP * 2), (LAS unsigned*)(raw + RAW_XV + i * 1024), 16, 0, 0); asm volatile("" ::: "memory"); }
}
template <bool WITH_Y> __device__ __forceinline__ void stage_a(LAS unsigned char* wb, int lane, float rkj, unsigned (&vt)[8], float mur, float muv, float& pr, float& pv) {
    const LAS unsigned short* kn = (const LAS unsigned short*)(wb + RAW_KN) + lane; const LAS unsigned short* bv = (const LAS unsigned short*)(wb + RAW_BV) + lane;
    const LAS unsigned short* kp = (const LAS unsigned short*)(wb + RAW_KP) + lane; const LAS unsigned short* xr = (const LAS unsigned short*)(wb + RAW_XR) + lane;
    const LAS unsigned short* xv = (const LAS unsigned short*)(wb + RAW_XV) + lane; const LAS unsigned short* wd = (const LAS unsigned short*)(wb + RAW_W) + lane;
    LAS unsigned short* XA = (LAS unsigned short*)(wb + D_XA) + lane; LAS unsigned short* XB = (LAS unsigned short*)(wb + D_XB) + lane;
    float gp = 1.f; unsigned bt[8], kt[8]; float bprev = 0.f, kprev = 0.f; float pd[16];
#pragma unroll
    for (int hf = 0; hf < 2; ++hf) {
        unsigned short rw[8], rkn[8], rbv[8], rkp[8], rxr[8];
#pragma unroll
        for (int tt = 0; tt < 8; ++tt) { const int t = 8 * hf + tt; rw[tt] = wd[t * 64]; rkn[tt] = kn[t * 64]; rbv[tt] = bv[t * 64]; rkp[tt] = kp[t * 64]; rxr[tt] = xr[t * 64]; }
        asm volatile("" ::: "memory");
#pragma unroll
        for (int tt = 0; tt < 8; ++tt) { const int t = 8 * hf + tt;
            const float w = __expf(-bfu(rw[tt])), a = bfu(rkn[tt]), b = bfu(rbv[tt]), k = bfu(rkp[tt]), rp = bfu(rxr[tt]); const float r = rp + (pr - rp) * mur; pr = rp;
            const float gc = gp * w, gi = __builtin_amdgcn_rcpf(gc);
            const float at = -a * gp, rt = r * gc, b2 = b * gi, k2 = k * gi;
            const unsigned war = cvtpk(at, rt), wbk = cvtpk(b2, k2);
            XA[t * (XA_PB / 2)] = (unsigned short)(war & 0xffffu); XA[(16 + t) * (XA_PB / 2)] = (unsigned short)(war >> 16);
            XB[t * (XA_PB / 2)] = (unsigned short)(wbk & 0xffffu); XB[(16 + t) * (XA_PB / 2)] = (unsigned short)(wbk >> 16);
            if (t & 1) { bt[t >> 1] = cvtpk(bprev, b2); kt[t >> 1] = cvtpk(kprev, k2); } else { bprev = b2; kprev = k2; }
            if (WITH_Y) pd[t] = r * k * rkj;
            gp = gc; }
        asm volatile("" ::: "memory");
    }
    if (WITH_Y) {
#pragma unroll
        for (int t = 0; t < 16; ++t) pd[t] = wave_sum(pd[t]);
        if (lane == 0) { LAS f4* o = (LAS f4*)(wb + D_RKK); o[0] = (f4){pd[0], pd[1], pd[2], pd[3]}; o[1] = (f4){pd[4], pd[5], pd[6], pd[7]}; o[2] = (f4){pd[8], pd[9], pd[10], pd[11]}; o[3] = (f4){pd[12], pd[13], pd[14], pd[15]}; } }
    *(LAS float*)(wb + D_GAM + lane * 4) = gp;
    { LAS v4u* row = (LAS v4u*)(wb + D_XBT + lane * XT_PB); row[0] = (v4u){bt[0], bt[1], bt[2], bt[3]}; row[1] = (v4u){bt[4], bt[5], bt[6], bt[7]}; row[2] = (v4u){kt[0], kt[1], kt[2], kt[3]}; row[3] = (v4u){kt[4], kt[5], kt[6], kt[7]}; }
#pragma unroll
    for (int t = 0; t < 8; ++t) { const float p0 = bfu(xv[(2 * t) * 64]), p1 = bfu(xv[(2 * t + 1) * 64]); vt[t] = cvtpk(p0 + (pv - p0) * muv, p1 + (p0 - p1) * muv); pv = p1; }
    asm volatile("" ::: "memory");
}
__device__ __forceinline__ void gram(LAS unsigned char* wb, int lane, f32x16& G) {
    const int tp = lane & 31, hi = lane >> 5; G = (f32x16){};
#pragma unroll
    for (int ks = 0; ks < 4; ++ks) { const bf16x8 a = *(const LAS bf16x8*)(wb + D_XB + tp * XA_PB + (16 * ks + 8 * hi) * 2), b = *(const LAS bf16x8*)(wb + D_XA + tp * XA_PB + (16 * ks + 8 * hi) * 2);
        G = __builtin_amdgcn_mfma_f32_32x32x16_bf16(a, b, G, 0, 0, 0); }
#pragma unroll
    for (int rg = 0; rg < 4; ++rg) { const int sb = 8 * rg + 4 * hi;
        if (tp < 16) { const int t = tp;
            if (rg < 2) { f4 m;
#pragma unroll
                for (int e = 0; e < 4; ++e) m[e] = (sb + e < t) ? G[4 * rg + e] : 0.f;
                (void)m; *(LAS u32x2*)(wb + D_ARHS + t * XT_PB + sb * 2) = (u32x2){0u, 0u}; }
            else { float m[4];
#pragma unroll
                for (int e = 0; e < 4; ++e) m[e] = (sb - 16 + e < t) ? G[4 * rg + e] : 0.f;
                *(LAS u32x2*)(wb + D_ARHS + t * XT_PB + sb * 2) = (u32x2){cvtpk(m[0], m[1]), cvtpk(m[2], m[3])}; } }
        else { const int t = tp - 16; float m[4];
#pragma unroll
            for (int e = 0; e < 4; ++e) m[e] = (((sb + e) & 15) <= t) ? G[4 * rg + e] : 0.f;
            *(LAS u32x2*)(wb + D_RA + t * XT_PB + sb * 2) = (u32x2){cvtpk(m[0], m[1]), cvtpk(m[2], m[3])}; } }
}
template <int NTB> __device__ __forceinline__ void s0_products(LAS unsigned char* wb, int lane, const f4 (&S)[4][4], f4 (&D)[NTB][4]) {
    const int n = lane & 15, q = lane >> 4;
#pragma unroll
    for (int tb = 0; tb < NTB; ++tb)
#pragma unroll
        for (int ib = 0; ib < 4; ++ib) D[tb][ib] = (f4){0.f, 0.f, 0.f, 0.f};
#pragma unroll
    for (int kk = 0; kk < 2; ++kk) { bf16x8 A[NTB];
#pragma unroll
        for (int tb = 0; tb < NTB; ++tb) { const LAS unsigned char* ap = wb + D_XA + (16 * tb + n) * XA_PB + (32 * kk + 4 * q) * 2; const u32x2 lo = *(const LAS u32x2*)ap, h2 = *(const LAS u32x2*)(ap + 32);
            A[tb] = __builtin_bit_cast(bf16x8, (v4u){lo.x, lo.y, h2.x, h2.y}); }
#pragma unroll
        for (int ib = 0; ib < 4; ++ib) { const bf16x8 B = pack_f8(S[2 * kk][ib], S[2 * kk + 1][ib]);
#pragma unroll
            for (int tb = 0; tb < NTB; ++tb) D[tb][ib] = mfma16(A[tb], B, D[tb][ib]); } }
}
__device__ __forceinline__ void solve_rows(LAS unsigned char* wb, int lane, const f4 (&RHT)[4], float (&g)[8]) {
    const int n = lane & 15, q = lane >> 4;
#pragma unroll
    for (int ib = 0; ib < 4; ++ib) *(LAS f4*)(wb + D_RH + ((16 * ib + n) * 16 + 4 * q) * 4) = RHT[ib];
    float sa[16];
    { const LAS f4* r4 = (const LAS f4*)(wb + D_RH + lane * 64);
#pragma unroll
        for (int c = 0; c < 4; ++c) { const f4 x = r4[c]; sa[4 * c] = x[0]; sa[4 * c + 1] = x[1]; sa[4 * c + 2] = x[2]; sa[4 * c + 3] = x[3]; } }
#pragma unroll
    for (int s = 0; s < 15; ++s) { const int hi = (s >> 2) & 1, r = (s & 3) + 4 * (s >> 3);
#pragma unroll
        for (int t = s + 1; t < 16; ++t) sa[t] += sa[s] * __int_as_float(__builtin_amdgcn_readlane(__float_as_int(g[r]), t + 32 * hi));
        asm volatile("" : "+v"(g[0]), "+v"(g[1]), "+v"(g[2]), "+v"(g[3]), "+v"(g[4]), "+v"(g[5]), "+v"(g[6]), "+v"(g[7])); }
    LAS v4u* row = (LAS v4u*)(wb + D_SVT + lane * SV_PB);
    row[0] = (v4u){cvtpk(sa[0], sa[1]), cvtpk(sa[2], sa[3]), cvtpk(sa[4], sa[5]), cvtpk(sa[6], sa[7])}; row[1] = (v4u){cvtpk(sa[8], sa[9]), cvtpk(sa[10], sa[11]), cvtpk(sa[12], sa[13]), cvtpk(sa[14], sa[15])};
}
template <bool WITH_Y> __device__ __forceinline__ void update_state(LAS unsigned char* wb, int lane, f4 (&S)[4][4], f4 (&YT)[4]) {
    const int n = lane & 15, q = lane >> 4; bf16x8 xb[4], ra;
#pragma unroll
    for (int jb = 0; jb < 4; ++jb) xb[jb] = *(const LAS bf16x8*)(wb + D_XBT + (16 * jb + n) * XT_PB + 16 * q);
    if (WITH_Y) ra = *(const LAS bf16x8*)(wb + D_RA + n * XT_PB + 16 * q);
#pragma unroll
    for (int ib = 0; ib < 4; ++ib) { const bf16x8 sv = *(const LAS bf16x8*)(wb + D_SVT + (16 * ib + n) * SV_PB + 16 * q);
        if (WITH_Y) YT[ib] = mfma16(ra, sv, YT[ib]);
#pragma unroll
        for (int jb = 0; jb < 4; ++jb) S[jb][ib] = mfma16(xb[jb], sv, S[jb][ib]); }
#pragma unroll
    for (int jb = 0; jb < 4; ++jb) { const f4 gm = *(const LAS f4*)(wb + D_GAM + (16 * jb + 4 * q) * 4);
#pragma unroll
        for (int ib = 0; ib < 4; ++ib) S[jb][ib] *= gm; }
}
__device__ __forceinline__ void load_state(const float* S0, int lane, f4 (&S)[4][4]) { const int n = lane & 15, q = lane >> 4;
#pragma unroll
    for (int jb = 0; jb < 4; ++jb)
#pragma unroll
        for (int ib = 0; ib < 4; ++ib) S[jb][ib] = *(const f4*)(S0 + (16 * ib + n) * 64 + 16 * jb + 4 * q); }
__device__ __forceinline__ void store_state(float* Sf, int lane, const f4 (&S)[4][4]) { const int n = lane & 15, q = lane >> 4;
#pragma unroll
    for (int jb = 0; jb < 4; ++jb)
#pragma unroll
        for (int ib = 0; ib < 4; ++ib) *(f4*)(Sf + (16 * ib + n) * 64 + 16 * jb + 4 * q) = S[jb][ib]; }
__device__ __forceinline__ void prev_init(const Params& p, size_t m0, int h, int lane, bool start, const float* shift0, float& pr, float& pv) {
    if (start) { pr = shift0 ? shift0[h * 64 + lane] : 0.f; pv = shift0 ? shift0[2048 + h * 64 + lane] : 0.f; }
    else { const bf16* q = (const bf16*)(p.ws + WS_PRW) + (m0 - 1) * RWCP + h * 64 + lane; pr = bfu(q[0]); pv = bfu(q[2048]); }
}
#define MS_LANDED() asm volatile("s_waitcnt vmcnt(0)" ::: "memory")
#define MS_LDS_DONE() asm volatile("s_waitcnt lgkmcnt(0)" ::: "memory")

__device__ __forceinline__ void scan_c(const Params& p, size_t m0, int h, int nsub, const float* S0, float* Sfin, bool start, const float* shift0, LAS unsigned char* wb, int lane) {
    const int n = lane & 15, q = lane >> 4;
    f4 S[4][4]; load_state(S0, lane, S);
    float lnw[4], lnb[4];
#pragma unroll
    for (int ib = 0; ib < 4; ++ib) { lnw[ib] = p.in[24][h * 64 + 16 * ib + n]; lnb[ib] = p.in[25][h * 64 + 16 * ib + n]; }
    const float rkj = p.in[23][h * 64 + lane], mur = p.in[15][h * 64 + lane], muv = p.in[15][2048 + h * 64 + lane]; float pr, pv; prev_init(p, m0, h, lane, start, shift0, pr, pv); const int loff = 4 * q * RWW + n;
    const bf16* Gt = (const bf16*)(p.ws + WS_G); bf16* Y = (bf16*)(p.ws + WS_YRW);
    raw_issue(p.ws, m0, h, lane, wb);
    typedef unsigned short us2 __attribute__((ext_vector_type(2))); us2 gn[4][2];
#pragma unroll
    for (int e = 0; e < 4; ++e)
#pragma unroll
        for (int ib = 0; ib < 4; ++ib) { const bf16* gb = Gt + m0 * RWW + h * 64; gn[e][ib >> 1][ib & 1] = gb[loff + e * RWW + 16 * ib]; }
#pragma unroll 1
    for (int k = 0; k < nsub; ++k) {
        const size_t mb = m0 + (size_t)k * SB;
        asm volatile("s_waitcnt vmcnt(16)" ::: "memory");
        unsigned vt[8]; stage_a<true>(wb, lane, rkj, vt, mur, muv, pr, pv);
        MS_LDS_DONE();
        if (k + 1 < nsub) raw_issue(p.ws, mb + SB, h, lane, wb);
        float g[8]; { f32x16 G; gram(wb, lane, G);
#pragma unroll
            for (int r = 0; r < 8; ++r) g[r] = G[r]; } asm volatile("" ::: "memory");
        { LAS v4u* row = (LAS v4u*)(wb + D_SVT + lane * SV_PB); row[0] = (v4u){0u, 0u, 0u, 0u}; row[1] = (v4u){0u, 0u, 0u, 0u}; row[2] = (v4u){vt[0], vt[1], vt[2], vt[3]}; row[3] = (v4u){vt[4], vt[5], vt[6], vt[7]}; }
        asm volatile("" ::: "memory");
        f4 D[2][4]; s0_products<2>(wb, lane, S, D); asm volatile("" ::: "memory");
        { const bf16x8 ar = *(const LAS bf16x8*)(wb + D_ARHS + n * XT_PB + 16 * q);
#pragma unroll
            for (int ib = 0; ib < 4; ++ib) { const bf16x8 sv = *(const LAS bf16x8*)(wb + D_SVT + (16 * ib + n) * SV_PB + 16 * q); D[0][ib] = mfma16(ar, sv, D[0][ib]); } }
        asm volatile("" ::: "memory"); solve_rows(wb, lane, D[0], g); asm volatile("" ::: "memory");
        update_state<true>(wb, lane, S, D[1]); asm volatile("" ::: "memory");
        const f4 rk4 = *(const LAS f4*)(wb + D_RKK + 16 * q); bf16* yb = Y + mb * RWW + h * 64;
        u32x2 vv[4];
#pragma unroll
        for (int ib = 0; ib < 4; ++ib) vv[ib] = *(const LAS u32x2*)(wb + D_SVT + (16 * ib + n) * SV_PB + (16 + 4 * q) * 2);
#pragma unroll
        for (int e = 0; e < 4; ++e) { float s1 = 0.f, s2 = 0.f;
#pragma unroll
            for (int ib = 0; ib < 4; ++ib) { const float y = D[1][ib][e]; s1 += y; s2 += y * y; }
            s1 = row16_sum(s1); s2 = row16_sum(s2);
            const float mean = s1 * (1.0f / 64.0f), var = fmaxf(s2 * (1.0f / 64.0f) - mean * mean, 0.f), rstd = __builtin_amdgcn_rsqf(var + 64e-5f);
#pragma unroll
            for (int ib = 0; ib < 4; ++ib) { const unsigned vw = (e < 2) ? vv[ib].x : vv[ib].y; const float v = (e & 1) ? bf_hi(vw) : bf_lo(vw);
                const float o = (((D[1][ib][e] - mean) * rstd) * lnw[ib] + lnb[ib] + rk4[e] * v) * bfu(gn[e][ib >> 1][ib & 1]);
                yb[loff + e * RWW + 16 * ib] = (unsigned short)(cvtpk(o, o) & 0xffffu); } }
        asm volatile("" ::: "memory");
        if (k + 1 < nsub) {
#pragma unroll
            for (int e = 0; e < 4; ++e)
#pragma unroll
                for (int ib = 0; ib < 4; ++ib) { const bf16* gb = Gt + (mb + SB) * RWW + h * 64; gn[e][ib >> 1][ib & 1] = gb[loff + e * RWW + 16 * ib]; } }
        asm volatile("" ::: "memory");
    }
    if (Sfin) store_state(Sfin, lane, S);
}
template <bool IS_P> __device__ __forceinline__ void scan_a1(const Params& p, int unit, LAS unsigned char* wb, int lane) {
    const int bh = unit / NCH, c = unit % NCH, b = bh >> 4, h = bh & 15, n = lane & 15, q = lane >> 4;
    const size_t m0 = (size_t)b * TP + (size_t)c * CH;
    const float mur = p.in[15][h * 64 + lane], muv = p.in[15][2048 + h * 64 + lane]; float pr, pv; prev_init(p, m0, h, lane, c == 0, nullptr, pr, pv);
    f4 S[4][4];
#pragma unroll
    for (int jb = 0; jb < 4; ++jb)
#pragma unroll
        for (int ib = 0; ib < 4; ++ib)
#pragma unroll
            for (int e = 0; e < 4; ++e) S[jb][ib][e] = (IS_P && ib == jb && n == 4 * q + e) ? 1.f : 0.f;
    raw_issue(p.ws, m0, h, lane, wb);
#pragma unroll 1
    for (int k = 0; k < CH / SB; ++k) {
        MS_LANDED();
        unsigned vt[8]; stage_a<false>(wb, lane, 0.f, vt, mur, muv, pr, pv);
        MS_LDS_DONE();
        if (k + 1 < CH / SB) raw_issue(p.ws, m0 + (size_t)(k + 1) * SB, h, lane, wb);
        float g[8]; { f32x16 G; gram(wb, lane, G);
#pragma unroll
            for (int r = 0; r < 8; ++r) g[r] = G[r]; } asm volatile("" ::: "memory");
        { LAS v4u* row = (LAS v4u*)(wb + D_SVT + lane * SV_PB); row[0] = (v4u){0u, 0u, 0u, 0u}; row[1] = (v4u){0u, 0u, 0u, 0u};
          if (IS_P) { row[2] = (v4u){0u, 0u, 0u, 0u}; row[3] = (v4u){0u, 0u, 0u, 0u}; } else { row[2] = (v4u){vt[0], vt[1], vt[2], vt[3]}; row[3] = (v4u){vt[4], vt[5], vt[6], vt[7]}; } }
        asm volatile("" ::: "memory");
        f4 D[1][4]; s0_products<1>(wb, lane, S, D); asm volatile("" ::: "memory");
        if (!IS_P) { const bf16x8 ar = *(const LAS bf16x8*)(wb + D_ARHS + n * XT_PB + 16 * q);
#pragma unroll
            for (int ib = 0; ib < 4; ++ib) { const bf16x8 sv = *(const LAS bf16x8*)(wb + D_SVT + (16 * ib + n) * SV_PB + 16 * q); D[0][ib] = mfma16(ar, sv, D[0][ib]); } }
        asm volatile("" ::: "memory"); solve_rows(wb, lane, D[0], g); asm volatile("" ::: "memory");
        f4 dummy[4]; update_state<false>(wb, lane, S, dummy); asm volatile("" ::: "memory");
    }
    if (!IS_P) store_state((float*)(p.ws + WS_UC) + (size_t)unit * 4096, lane, S);
    else { float* Po = (float*)(p.ws + WS_PC) + (size_t)unit * 4096;
#pragma unroll
        for (int jb = 0; jb < 4; ++jb)
#pragma unroll
            for (int ib = 0; ib < 4; ++ib)
#pragma unroll
                for (int e = 0; e < 4; ++e) Po[((jb * 4 + ib) * 64 + ((n >> 2) & 3) * 16 + 4 * q + e) * 4 + (n & 3)] = S[jb][ib][e]; }
}
__device__ __forceinline__ void scan_a(const Params& p, int unit, LAS unsigned char* wb, int lane) {
    const int bh = unit / NCH, c = unit % NCH, b = bh >> 4, h = bh & 15, n = lane & 15, q = lane >> 4;
    const size_t m0 = (size_t)b * TP + (size_t)c * CH;
    const float mur = p.in[15][h * 64 + lane], muv = p.in[15][2048 + h * 64 + lane]; float pr, pv; prev_init(p, m0, h, lane, c == 0, nullptr, pr, pv);
    f4 U[4][4], P[4][4];
#pragma unroll
    for (int jb = 0; jb < 4; ++jb)
#pragma unroll
        for (int ib = 0; ib < 4; ++ib) { U[jb][ib] = (f4){0.f, 0.f, 0.f, 0.f};
#pragma unroll
            for (int e = 0; e < 4; ++e) P[jb][ib][e] = (ib == jb && n == 4 * q + e) ? 1.f : 0.f; }
    raw_issue(p.ws, m0, h, lane, wb);
#pragma unroll 1
    for (int k = 0; k < CH / SB; ++k) {
        MS_LANDED();
        unsigned vt[8]; stage_a<false>(wb, lane, 0.f, vt, mur, muv, pr, pv);
        MS_LDS_DONE();
        if (k + 1 < CH / SB) raw_issue(p.ws, m0 + (size_t)(k + 1) * SB, h, lane, wb);
        float g[8]; { f32x16 G; gram(wb, lane, G);
#pragma unroll
            for (int r = 0; r < 8; ++r) g[r] = G[r]; } asm volatile("" ::: "memory");
        { LAS v4u* row = (LAS v4u*)(wb + D_SVT + lane * SV_PB); row[0] = (v4u){0u, 0u, 0u, 0u}; row[1] = (v4u){0u, 0u, 0u, 0u}; row[2] = (v4u){vt[0], vt[1], vt[2], vt[3]}; row[3] = (v4u){vt[4], vt[5], vt[6], vt[7]}; }
        asm volatile("" ::: "memory");
        f4 DU[1][4], DP[1][4]; s0_products<1>(wb, lane, U, DU); s0_products<1>(wb, lane, P, DP); asm volatile("" ::: "memory");
        f4 dummy[4];
        { const bf16x8 ar = *(const LAS bf16x8*)(wb + D_ARHS + n * XT_PB + 16 * q);
#pragma unroll
            for (int ib = 0; ib < 4; ++ib) { const bf16x8 sv = *(const LAS bf16x8*)(wb + D_SVT + (16 * ib + n) * SV_PB + 16 * q); DU[0][ib] = mfma16(ar, sv, DU[0][ib]); } }
        asm volatile("" ::: "memory"); solve_rows(wb, lane, DU[0], g); asm volatile("" ::: "memory");
        update_state<false>(wb, lane, U, dummy); asm volatile("" ::: "memory");
        solve_rows(wb, lane, DP[0], g); asm volatile("" ::: "memory");
        { LAS v4u* row = (LAS v4u*)(wb + D_SVT + lane * SV_PB); row[2] = (v4u){0u, 0u, 0u, 0u}; row[3] = (v4u){0u, 0u, 0u, 0u}; }
        asm volatile("" ::: "memory");
        update_state<false>(wb, lane, P, dummy);
    }
    store_state((float*)(p.ws + WS_UC) + (size_t)unit * 4096, lane, U);
    float* Po = (float*)(p.ws + WS_PC) + (size_t)unit * 4096;
#pragma unroll
    for (int jb = 0; jb < 4; ++jb)
#pragma unroll
        for (int ib = 0; ib < 4; ++ib)
#pragma unroll
            for (int e = 0; e < 4; ++e) Po[((jb * 4 + ib) * 64 + ((n >> 2) & 3) * 16 + 4 * q + e) * 4 + (n & 3)] = P[jb][ib][e];
}
}
constexpr int N_PHASES = 16;
#ifndef MK_SPLIT
#define MK_SPLIT 0
#endif
__global__ void __launch_bounds__(NWAVES * 64, 2) fwd_kernel(Params p) {
    extern __shared__ __attribute__((aligned(16))) unsigned char lds_raw[];
    LAS unsigned char* lds = (LAS unsigned char*)lds_raw;
    volatile LAS unsigned* MISC = (volatile LAS unsigned*)(lds + MISC_OFF);
    const int tid = threadIdx.x, lane = tid & 63, wave = __builtin_amdgcn_readfirstlane(tid >> 6);
    const int G = gridDim.x, gw = blockIdx.x * NWAVES + wave, NGW = G * NWAVES;
    unsigned char* ws = p.ws;
    for (int u = tid; u < (LDS_BYTES - LDSCTL_OFF) / 4; u += NWAVES * 64) ((LAS unsigned*)(lds + LDSCTL_OFF))[u] = 0u;
    __syncthreads();
    XcdBarrier bar; bar.bar = (unsigned*)(ws + WS_CTL) + CW_BAR; bar.x = 0; bar.st = nullptr;
    if (!MK_SPLIT) bar = xcd_barrier_post((unsigned*)(ws + WS_CTL) + CW_BAR, MISC + 8);
    const int lo = p.ph_lo, hi = p.ph_hi;
#define IN(k) (lo <= (k) && (k) < hi)
#define SEAM(k) do { if (IN(k) && IN((k) + 1)) xcd_barrier(bar); } while (0)
#ifndef REP_MASK
#define REP_MASK 0
#endif
#define PH_BEGIN(k) if (IN(k)) { {
#define PH_END(k) } } SEAM(k);
    using pg8::Gemm; using pg8::StaticOrderT;
    bf16* XN = (bf16*)(ws + WS_XN); bf16* HB = (bf16*)(ws + WS_H); bf16* HRES = (bf16*)(ws + WS_HRES); float* PART = (float*)(ws + WS_PART); float* SS1 = (float*)(ws + WS_CTL) + CW_SS1; float* SS2 = (float*)(ws + WS_CTL) + CW_SS2;
    const int tail_uu = ((int)blockIdx.x & 7) + 8 * (((int)blockIdx.x >> 3) / TailSO::SF);

    PH_BEGIN(0) { p0_prologue(p, lds, gw, NGW, wave, lane); }
    PH_END(0)
    PH_BEGIN(1) { Gemm g{XN, (const bf16*)(ws + WS_W1GU), M, NGU, DM}; typedef StaticOrderT<M, NGU, DM> SO; SO S; S.init((int)blockIdx.x); pg8::EpiGateUp E{HB, DFF, (const float*)(ws + WS_CTL) + CW_SS0, 0};
        pg8::gemm_phase<pg8::EpiGateUp, SO, true, true>(lds + RING_OFF, g, S, E);
        constexpr int NLONG = SO::nwg - SO::full * pg8::GRID;
        if ((int)blockIdx.x >= NLONG) conv_w1d(p, (LAS float*)(lds + RING_OFF + wave * 16384), ((int)blockIdx.x - NLONG) * NWAVES + wave, (G - NLONG) * NWAVES, lane); }
    PH_END(1)
    PH_BEGIN(2) { Gemm g{HB, (const bf16*)(ws + WS_W1D), M, DM, DFF}; typedef StaticOrderT<M, DM, DFF, true> SO; SO S; S.init((int)blockIdx.x); typedef pg8::EpiResid<true, true> EP; EP E{XN, XN, HRES, DM, 0.5f, DFF / 64, PART, tail_uu, SS1};
        pg8::gemm_phase<EP, SO, true, true>(lds + RING_OFF, g, S, E); }
    PH_END(2)
    PH_BEGIN(3) tail_combine_h(XN, 0.5f, PART, HRES, SS1, gw, NGW, lane);
    PH_END(3)
    PH_BEGIN(4) { Gemm g{HRES, (const bf16*)(ws + WS_WIN), M, NWIN, DM}; typedef StaticOrderT<M, NWIN, DM, false, 5> SO; SO S; S.init((int)blockIdx.x);
        pg8::EpiWin E{(bf16*)(ws + WS_QB), p.out + O_KP, p.out + O_KS, p.out + O_VP, p.out + O_VS, (bf16*)(ws + WS_PRW), (unsigned char*)(ws + WS_GSB), (unsigned char*)(ws + WS_GRW), p.out + O_SHP, p.out + O_SHS, p.in[12], p.in[13], SS1};
        pg8::gemm_phase<pg8::EpiWin, SO, true, true>(lds + RING_OFF, g, S, E); }
    PH_END(4)
    PH_BEGIN(5) { shift_phase(p, gw, NGW, lane); }
    PH_END(5)
    PH_BEGIN(6) { Gemm g{(const bf16*)(ws + WS_ACAT), (const bf16*)(ws + WS_WLORA), M, NLORA, KLORA}; typedef pg8::LoraOrderT<M> SO; SO S; S.init((int)blockIdx.x);
        pg8::EpiLora E{(bf16*)(ws + WS_WD), (bf16*)(ws + WS_KP), (bf16*)(ws + WS_KKN), (bf16*)(ws + WS_BV), (bf16*)(ws + WS_G), (const bf16*)(ws + WS_PRW), p.in[15] + 1024, p.in[5] + 1024, p.in[16], p.in[18], p.in[21], p.in[22]};
        pg8::gemm_phase<pg8::EpiLora, SO, true, true>(lds + RING_OFF, g, S, E); }
    PH_END(6)
#if MSCAN && !defined(MS_NO_A)
    PH_BEGIN(7) { if (wave < 4) { __builtin_amdgcn_s_setprio(3);
            for (int u = (int)blockIdx.x * 4 + wave; u < 32 * NCH; u += G * 4) ms::scan_a(p, u, lds + RING_OFF + wave * ms::WAVE_BYTES, lane);
            __builtin_amdgcn_s_setprio(0); }
        attn_phase(p, wave < 4 ? lds + RING_OFF + wave * ms::WAVE_BYTES : lds + ATT2_OFF + (wave - 4) * VT_BYTES, (unsigned*)(ws + WS_CTL) + CW_ATTQ, 0, ATT_N1, lane); }
#else
    PH_BEGIN(7) { for (int u = gw; u < 32 * NCH; u += NGW) scan_pass_a(p, u, lds + RING_OFF + wave * SC_WAVE, lane); }
#endif
    PH_END(7)
    PH_BEGIN(8) {
#if MSCAN && !defined(MS_NO_C)
        if (wave < 3) __builtin_amdgcn_s_setprio(3);
        if (wave < 2) for (int u = (int)blockIdx.x * 2 + wave; u < NBS * 16; u += G * 2) { const int s = u >> 4, h = u & 15;
            ms::scan_c(p, (size_t)MPROMPT + (size_t)s * TS, h, TS / ms::SB, p.in[4] + (size_t)u * 4096, p.out + O_WKVS + (size_t)u * 4096, true, p.in[5] + (size_t)s * RWC, lds + RING_OFF + wave * ms::WAVE_BYTES, lane); }
        if (wave == 2) for (int u = blockIdx.x; u < 128; u += G) scan_pass_b(p, u, lane);
        if (wave < 3) __builtin_amdgcn_s_setprio(0);
        attn_phase(p, lds + RING_OFF + 2 * ms::WAVE_BYTES + wave * VT_BYTES, (unsigned*)(ws + WS_CTL) + CW_ATTQ + 32, ATT_N1, ATT_N2 - ATT_N1, lane);
#else
        if (wave == 0) for (int u = blockIdx.x; u < 128; u += G) scan_pass_b(p, u, lane);
        if (wave < 4) { const int vw = ((int)((blockIdx.x + G - (128 % G)) % G)) * 4 + wave;
            for (int u = vw; u < NBS * 16; u += G * 4) { const int s = u >> 4, h = u & 15;
                scan_pass_c(p, (size_t)MPROMPT + (size_t)s * TS, h, TS, p.in[4] + (size_t)u * 4096, p.out + O_WKVS + (size_t)u * 4096, lds + RING_OFF + wave * SC_WAVE, lane); } }
        attn_phase(p, lds + RING_OFF + wave * ATT_WAVE_STRIDE, (unsigned*)(ws + WS_CTL) + CW_ATTQ + 32, ATT_N1, ATT_N2 - ATT_N1, lane);
#endif
    }
    PH_END(8)
#if MSCAN && !defined(MS_NO_C)
    PH_BEGIN(9) { if (wave < 4) __builtin_amdgcn_s_setprio(3);
        if (wave < 4) for (int u = (int)blockIdx.x * 4 + wave; u < 32 * NCH; u += G * 4) { const int bh = u / NCH, c = u % NCH;
            ms::scan_c(p, (size_t)(bh >> 4) * TP + (size_t)c * CH, bh & 15, CH / ms::SB, (const float*)(ws + WS_SC) + (size_t)u * 4096, nullptr, c == 0, nullptr, lds + RING_OFF + wave * ms::WAVE_BYTES, lane); }
        if (wave < 4) __builtin_amdgcn_s_setprio(0);
        attn_phase(p, wave < 4 ? lds + RING_OFF + wave * ms::WAVE_BYTES : lds + ATT2_OFF + (wave - 4) * VT_BYTES, (unsigned*)(ws + WS_CTL) + CW_ATTQ + 64, ATT_N2, N_ATT_UNITS - ATT_N2, lane);
        if (wave >= 4) late_convert(p, (LAS float*)(lds + ATT2_OFF + (wave - 4) * VT_BYTES), (int)blockIdx.x * 4 + (wave - 4), G * 4, lane); }
#else
    PH_BEGIN(9) { for (int u = gw; u < 32 * NCH; u += NGW) { const int bh = u / NCH, c = u % NCH;
            scan_pass_c(p, (size_t)(bh >> 4) * TP + (size_t)c * CH, bh & 15, CH, (const float*)(ws + WS_SC) + (size_t)u * 4096, nullptr, lds + RING_OFF + wave * SC_WAVE, lane); } }
#endif
    PH_END(9)
    PH_BEGIN(10) { unsigned* MFLAG = (unsigned*)(ws + WS_CTL) + CW_MFLAG;
        { Gemm g{(const bf16*)(ws + WS_AO), (const bf16*)(ws + WS_WSBO), M, DM, SBW}; pg8::EpiMerge<1> E{(const unsigned char*)(ws + WS_GSB), (bf16*)(ws + WS_H), XN};
          typedef pg8::MergeOrderT<1, M, DM, SBW> SO; SO S; S.init((int)blockIdx.x, MFLAG);
          pg8::gemm_phase<pg8::EpiMerge<1>, SO, true, true>(lds + RING_OFF, g, S, E); }
        { Gemm g{(const bf16*)(ws + WS_YRW), (const bf16*)(ws + WS_WRWO), M, DM, RWW}; pg8::EpiMerge<2> E{(const unsigned char*)(ws + WS_GRW), (bf16*)(ws + WS_H), XN};
          typedef pg8::MergeOrderT<2, M, DM, RWW> SO; SO S; S.init((int)blockIdx.x, MFLAG);
          pg8::gemm_phase<pg8::EpiMerge<2>, SO, true, true>(lds + RING_OFF, g, S, E); } }
    PH_END(10)
    PH_BEGIN(11) { Gemm g{XN, (const bf16*)(ws + WS_WOUT), M, DM, DM}; typedef StaticOrderT<M, DM, DM> SO; SO S; S.init((int)blockIdx.x); typedef pg8::EpiResid<true, true> EP; EP E{HRES, HRES, HRES, DM, 1.0f, DM / 64, PART, tail_uu, SS2};
        pg8::gemm_phase<EP, SO, true, true>(lds + RING_OFF, g, S, E); }
    PH_END(11)
    PH_BEGIN(13) { Gemm g{HRES, (const bf16*)(ws + WS_W2GU), M, NGU, DM}; typedef StaticOrderT<M, NGU, DM> SO; SO S; S.init((int)blockIdx.x); pg8::EpiGateUp E{HB, DFF, SS2, 0};
        pg8::gemm_phase<pg8::EpiGateUp, SO, true, true>(lds + RING_OFF, g, S, E); }
    PH_END(13)
    PH_BEGIN(14) { Gemm g{HB, (const bf16*)(ws + WS_W2D), M, DM, DFF}; typedef StaticOrderT<M, DM, DFF, true> SO; SO S; S.init((int)blockIdx.x); typedef pg8::EpiResid<true, false> EP; EP E{HRES, HRES, p.out + O_Y, DM, 0.5f, DFF / 64, PART, tail_uu, nullptr};
        pg8::gemm_phase<EP, SO, true, true>(lds + RING_OFF, g, S, E); }
    PH_END(14)
    PH_BEGIN(15) tail_combine(HRES, 0.5f, PART, p.out + O_Y, gw, NGW, lane);
    } }
#undef IN
#undef SEAM
}

extern "C" void kernel_launch(void* const* d_in, const int* in_sizes, int n_in, void* d_out, int out_size, void* d_ws, size_t ws_size, hipStream_t stream) {
    static int grid = 0;
    if (grid == 0) {
        if (n_in != 32 || (size_t)out_size != O_END || ws_size < WS_END) { fprintf(stderr, "kernel_launch: unexpected sizes n_in %d out %d ws %zu (need %zu)\n", n_in, out_size, ws_size, (size_t)WS_END); grid = -1; return; }
        int dev = 0, cus = 0, per_cu = 0;
        if (hipGetDevice(&dev) != hipSuccess || hipDeviceGetAttribute(&cus, hipDeviceAttributeMultiprocessorCount, dev) != hipSuccess) { grid = -1; return; }
        if (hipFuncSetAttribute((const void*)fwd_kernel, hipFuncAttributeMaxDynamicSharedMemorySize, LDS_BYTES) != hipSuccess) { fprintf(stderr, "kernel_launch: hipFuncSetAttribute failed\n"); grid = -1; return; }
        if (hipOccupancyMaxActiveBlocksPerMultiprocessor(&per_cu, (const void*)fwd_kernel, NWAVES * 64, LDS_BYTES) != hipSuccess || per_cu < 1) { fprintf(stderr, "kernel_launch: occupancy query says %d\n", per_cu); (void)hipGetLastError(); per_cu = 1; }
        if (cus < pg8::GRID) { fprintf(stderr, "kernel_launch: built for a %d-CU device, found %d\n", pg8::GRID, cus); grid = -1; return; }
        grid = pg8::GRID;
    }
    if (grid < 0) return;
    if (hipMemsetAsync((char*)d_ws + WS_CTL, 0, CTL_ZERO_BYTES, stream) != hipSuccess) return;
    Params p{};
    for (int i = 0; i < 32; ++i) p.in[i] = (const float*)d_in[i];
    p.out = (float*)d_out; p.ws = (unsigned char*)d_ws;
#if MK_SPLIT
    for (int ph = 0; ph < N_PHASES; ++ph) for (int rep = 0; rep < (((REP_MASK >> ph) & 1) ? 2 : 1); ++rep) { p.ph_lo = ph; p.ph_hi = ph + 1; hipLaunchKernelGGL(fwd_kernel, dim3(grid), dim3(NWAVES * 64), LDS_BYTES, stream, p); }
#else
    p.ph_lo = 0; p.ph_hi = N_PHASES; hipLaunchKernelGGL(fwd_kernel, dim3(grid), dim3(NWAVES * 64), LDS_BYTES, stream, p);
#endif
}
```

```cpp
#include <hip/hip_runtime.h>
#include <cstdio>
#include <cstdint>
#ifndef ATT_SPLIT1
#define ATT_SPLIT1 4500
#define ATT_SPLIT2 6450
#endif
#ifndef MSCAN
#define MSCAN 1
#endif
namespace pg8 {
#define PG8_LAS __attribute__((address_space(3)))
typedef unsigned short bf16_t;
typedef short bf16x8 __attribute__((ext_vector_type(8)));
typedef float f32x4 __attribute__((ext_vector_type(4)));
typedef unsigned u32x4 __attribute__((ext_vector_type(4)));
constexpr int BM = 256, BK = 64, HALF = 128, HTB = HALF * BK * 2  , STAGE_BYTES = 8 * HTB, NXCD = 8, WGM = 8;

__host__ __device__ __forceinline__ int lds_byte(int r, int c) { const int st = (r >> 4) * 2 + (c >> 5), rr = r & 15, cc = c & 31, ob = rr * 64 + cc * 2; return st * 1024 + (ob ^ (((ob >> 9) & 1) << 5)); }
__host__ __device__ __forceinline__ void stage_rc(int b, int& R, int& C) { const int st = b / 1024, sb = b % 1024, swz = sb ^ (((sb >> 9) & 1) << 5); R = (st >> 1) * 16 + swz / 64; C = (st & 1) * 32 + (swz % 64) / 2; }
__host__ __device__ __forceinline__ int perm32(int rho) { const int n = rho >> 4, i = rho & 15; return 8 * (i >> 2) + 4 * n + (i & 3); }

struct Unit { int pm, pn, kt0, nkt; };
struct Gemm { const bf16_t* A; const bf16_t* Bt; int M, N, K; };

__host__ __device__ __forceinline__ int tile_of(int L, int nM, int nN) {
    const int nwg = nM * nN; int wgid = L; { const int q = nwg / NXCD, r = nwg % NXCD, xcd = wgid % NXCD, off = wgid / NXCD; wgid = (xcd < r ? xcd * (q + 1) : r * (q + 1) + (xcd - r) * q) + off; }
    const int wgm = nN <= 8 ? 4 : WGM;
    const int nig = wgm * nN, gid = wgid / nig, fm = gid * wgm, gsz = (nM - fm) < wgm ? (nM - fm) : wgm;
    return (fm + ((wgid % nig) % gsz)) | (((wgid % nig) / gsz) << 16);
}
constexpr int GRID = 256;
template <int M_, int N_, int K_, bool SPLIT = false> struct StaticOrderT {
    static constexpr int nM = M_ / BM, nN = N_ / BM, nwg = nM * nN, nt = K_ / BK, full = nwg / GRID, R = nwg - full * GRID;
    static constexpr int SF0 = (SPLIT && R > 0 && GRID % R == 0 && R % NXCD == 0) ? GRID / R : 1;
    static constexpr int SF = (SF0 > 1 && nt % SF0 == 0 && ((nt / SF0) & 1) == 0) ? SF0 : 1;
    static constexpr int TAIL_UNITS = SF > 1 ? R : 0;
    int c;
    __host__ __device__ void init(int c_) { c = c_; }
    __host__ __device__ bool next(int i, Unit& u) const {
        const bool tail = SF > 1 && i == full;
        const int L = tail ? full * GRID + (c % NXCD) + NXCD * ((c / NXCD) / SF) : i * GRID + c;
        if (!tail && (L >= nwg || (SF > 1 && i > full))) return false;
        const int t = tile_of(L, nM, nN);
        Unit r; r.pm = t & 0xffff; r.pn = t >> 16; r.nkt = tail ? nt / SF : nt; r.kt0 = tail ? ((c / NXCD) % SF) * (nt / SF) : 0; u = r; return true;
    }
    __device__ __forceinline__ void a_ready(const Unit&, int) const {}
    __device__ __forceinline__ void done(const Unit&, int) const {}
};
template <int WHICH, int M_, int N_, int K_> struct MergeOrderT {
    static constexpr int nM = M_ / BM, nN = N_ / BM, nt = K_ / BK, FULL = (nM * nN) / GRID, R = nM * nN - FULL * GRID;
    static_assert(FULL == 2 && R == 64, "deal written for 2.25 rounds");
    int c; unsigned* flags;
    __device__ __forceinline__ void init(int c_, unsigned* f) { c = c_; flags = f; }
    __device__ __forceinline__ int tileL(int i) const {
        if (WHICH == 1) { if (c < R) return i == 0 ? FULL * GRID + c : (i <= FULL ? (i - 1) * GRID + c : -1); return i < FULL ? i * GRID + c : -1; }
        if (i < FULL) return i * GRID + c;
        return (i == FULL && c >= R && c < 2 * R) ? FULL * GRID + c - R : -1; }
    __device__ __forceinline__ bool next(int i, Unit& u) const {
        const int L = tileL(i); if (L < 0) return false;
        const int t = tile_of(L, nM, nN); Unit r; r.pm = t & 0xffff; r.pn = t >> 16; r.kt0 = 0; r.nkt = nt; u = r; return true; }
    __device__ __forceinline__ void a_ready(const Unit&, int i) const {
        if (WHICH != 2 || i != FULL) return;
        unsigned* f = flags + (c - R) * 32;
        for (int spin = 0; spin < 200000; ++spin) { if (__hip_atomic_load(f, __ATOMIC_RELAXED, __HIP_MEMORY_SCOPE_AGENT) != 0u) break; __builtin_amdgcn_s_sleep(8); }
        __builtin_amdgcn_fence(__ATOMIC_ACQUIRE, "agent");
    }
    __device__ __forceinline__ void done(const Unit&, int i) const {
        if (WHICH != 1 || c >= R || i != 0) return;
        asm volatile("s_waitcnt vmcnt(0)" ::: "memory");
        __builtin_amdgcn_s_barrier();
        if (threadIdx.x == 0) { __builtin_amdgcn_fence(__ATOMIC_RELEASE, "agent"); asm volatile("s_waitcnt vmcnt(0)" ::: "memory");
            __hip_atomic_store(flags + c * 32, 1u, __ATOMIC_RELAXED, __HIP_MEMORY_SCOPE_AGENT); }
    }
};
template <int M_> struct LoraOrderT {
    static constexpr int nM = M_ / BM, nN = 12, nwg = nM * nN;
    int c;
    __host__ __device__ void init(int c_) { c = c_; }
    __host__ __device__ bool next(int i, Unit& u) const {
        const int L = i * GRID + c; if (L >= nwg) return false;
        const int t = tile_of(L, nM, nN); Unit r; r.pm = t & 0xffff; r.pn = t >> 16; const int type = r.pn >> 2; r.kt0 = type == 0 ? 0 : (type == 1 ? 2 : 4); r.nkt = type == 2 ? 4 : 2; u = r; return true;
    }
    __device__ __forceinline__ void a_ready(const Unit&, int) const {}
    __device__ __forceinline__ void done(const Unit&, int) const {}
};

typedef float f32x2_t __attribute__((ext_vector_type(2))); typedef __bf16 bf16x2_t __attribute__((ext_vector_type(2)));
__device__ __forceinline__ unsigned cvt_pk_bf16(float lo, float hi) { const f32x2_t v = {lo, hi}; const bf16x2_t b = __builtin_convertvector(v, bf16x2_t); return __builtin_bit_cast(unsigned, b); }
typedef unsigned u32x2 __attribute__((ext_vector_type(2)));
__device__ __forceinline__ u32x4 pack8(const f32x4 a, const f32x4 b) { u32x4 w; w.x = cvt_pk_bf16(a[0], a[1]); w.y = cvt_pk_bf16(a[2], a[3]); w.z = cvt_pk_bf16(b[0], b[1]); w.w = cvt_pk_bf16(b[2], b[3]); return w; }
__device__ __forceinline__ float bflo(unsigned w) { return __uint_as_float(w << 16); }
__device__ __forceinline__ float bfhi(unsigned w) { return __uint_as_float(w & 0xffff0000u); }
__device__ __forceinline__ void unpack8(const u32x4 w, f32x4& a, f32x4& b) { a = (f32x4){bflo(w.x), bfhi(w.x), bflo(w.y), bfhi(w.y)}; b = (f32x4){bflo(w.z), bfhi(w.z), bflo(w.w), bfhi(w.w)}; }
__device__ __forceinline__ float xsum16(float x) { const auto r = __builtin_amdgcn_permlane16_swap(__float_as_uint(x), __float_as_uint(x), false, false); return __uint_as_float(r[0]) + __uint_as_float(r[1]); }
__device__ __forceinline__ float xsum32(float x) { const auto r = __builtin_amdgcn_permlane32_swap(__float_as_uint(x), __float_as_uint(x), false, false); return __uint_as_float(r[0]) + __uint_as_float(r[1]); }
__device__ __forceinline__ float sigm(float x) { return __builtin_amdgcn_rcpf(1.0f + __expf(-x)); }
__device__ __forceinline__ f32x4 sigm4(const f32x4 x) { return (f32x4){sigm(x[0]), sigm(x[1]), sigm(x[2]), sigm(x[3])}; }
constexpr int MP = 16384;

struct EpiGateUp {
    static constexpr bool PERM = true, AFTER_DRAIN = false;
    bf16_t* H; int ldh; const float* ss; int tiledM;
    __device__ __forceinline__ void operator()(const f32x4 (&acc)[2][2][4][2], const Unit& u, int wr, int wc, int fr, int fq) const {
        const int row0 = u.pm * BM + wr * 64 + fr, col0 = u.pn * 128 + wc * 32 + 8 * fq;
#pragma unroll
        for (int ai = 0; ai < 2; ++ai)
#pragma unroll
            for (int m = 0; m < 4; ++m) { const int row = row0 + ai * HALF + m * 16; bf16_t* rowp = tiledM ? H + ((size_t)(col0 >> 6) * tiledM + row) * 64 + (col0 & 63) : H + (size_t)row * ldh + col0;
                const float rs = ss ? __builtin_amdgcn_rsqf(ss[row] * (1.0f / 2048.0f) + 1e-6f) : 1.0f;
                const f32x4 g0 = acc[ai][0][m][0] * rs, g1 = acc[ai][0][m][1] * rs, u0 = acc[ai][1][m][0] * rs, u1 = acc[ai][1][m][1] * rs;
                const f32x4 h0 = g0 * sigm4(g0) * u0, h1 = g1 * sigm4(g1) * u1;
                *(u32x4*)rowp = pack8(h0, h1); }
    }
};
template <bool BASE_BF16, bool OUT_BF16> struct EpiResid {
    static constexpr bool PERM = true, AFTER_DRAIN = false;
    const void* b0; const void* b1; void* out; int ld; float scale; int ntfull; float* part; int uu; float* ss;
    __device__ __forceinline__ void operator()(const f32x4 (&acc)[2][2][4][2], const Unit& u, int wr, int wc, int fr, int fq) const {
        if (u.nkt == ntfull) {
            const void* base = (u.pm * BM < MP) ? b0 : b1;
            const int row0 = u.pm * BM + wr * 64 + fr, col0 = u.pn * BM + wc * 32 + 8 * fq;
#pragma unroll
            for (int ai = 0; ai < 2; ++ai) { f32x4 bs[4][2][2];
#pragma unroll
                for (int m = 0; m < 4; ++m) { const size_t off = (size_t)(row0 + ai * HALF + m * 16) * ld + col0;
#pragma unroll
                    for (int bj = 0; bj < 2; ++bj) {
                        if (BASE_BF16) unpack8(*(const u32x4*)((const bf16_t*)base + off + bj * HALF), bs[m][bj][0], bs[m][bj][1]);
                        else { bs[m][bj][0] = *(const f32x4*)((const float*)base + off + bj * HALF); bs[m][bj][1] = *(const f32x4*)((const float*)base + off + bj * HALF + 4); } } }
#pragma unroll
                for (int m = 0; m < 4; ++m) { const size_t off = (size_t)(row0 + ai * HALF + m * 16) * ld + col0; float sq = 0.f;
#pragma unroll
                    for (int bj = 0; bj < 2; ++bj) { const f32x4 v0 = bs[m][bj][0] + acc[ai][bj][m][0] * scale, v1 = bs[m][bj][1] + acc[ai][bj][m][1] * scale;
                        sq += (v0[0] * v0[0] + v0[1] * v0[1]) + (v0[2] * v0[2] + v0[3] * v0[3]) + (v1[0] * v1[0] + v1[1] * v1[1]) + (v1[2] * v1[2] + v1[3] * v1[3]);
                        if (OUT_BF16) *(u32x4*)((bf16_t*)out + off + bj * HALF) = pack8(v0, v1);
                        else { *(f32x4*)((float*)out + off + bj * HALF) = v0; *(f32x4*)((float*)out + off + bj * HALF + 4) = v1; } }
                    if (ss) { sq = xsum32(xsum16(sq)); if (fq == 0) unsafeAtomicAdd(ss + row0 + ai * HALF + m * 16, sq); } }
                asm volatile("" ::: "memory"); }
        } else {
            bf16_t* pp = (bf16_t*)part + (size_t)(uu * 4 + u.kt0 / u.nkt) * 65536 + (wr * 64 + fr) * 256 + wc * 32 + 8 * fq;
#pragma unroll
            for (int ai = 0; ai < 2; ++ai)
#pragma unroll
                for (int m = 0; m < 4; ++m)
#pragma unroll
                    for (int bj = 0; bj < 2; ++bj) *(u32x4*)(pp + (ai * HALF + m * 16) * 256 + bj * HALF) = pack8(acc[ai][bj][m][0], acc[ai][bj][m][1]);
        }
    }
};
struct EpiWin {
    static constexpr bool PERM = true, AFTER_DRAIN = false;
    bf16_t* Qb; float* Kp; float* Ks; float* Vp; float* Vs; bf16_t* PRW; unsigned char* GSB; unsigned char* GRW; float* SHp;
     float* SHs; const float* qg; const float* kg; const float* ss;
    __device__ __forceinline__ void operator()(const f32x4 (&acc)[2][2][4][2], const Unit& u, int wr, int wc, int fr, int fq) const {
        const int pn = u.pn, rowb = u.pm * BM + wr * 64 + fr; const bool prompt = u.pm * BM < MP;
        float rsr[2][4];
#pragma unroll
        for (int ai = 0; ai < 2; ++ai)
#pragma unroll
            for (int m = 0; m < 4; ++m) rsr[ai][m] = __builtin_amdgcn_rsqf(ss[rowb + ai * HALF + m * 16] * (1.0f / 2048.0f) + 1e-6f);
#define ACCS(ai, bj, m, n) (acc[ai][bj][m][n] * rsr[ai][m])
        if (pn < 8) {
            const bool isq = pn < 4; const int head = 4 * (pn & 3) + wc; const float* gain = isq ? qg : kg;
            f32x4 gv[2][2];
#pragma unroll
            for (int bj = 0; bj < 2; ++bj)
#pragma unroll
                for (int n = 0; n < 2; ++n) gv[bj][n] = *(const f32x4*)(gain + 32 * bj + 8 * fq + 4 * n);
#pragma unroll
            for (int ai = 0; ai < 2; ++ai)
#pragma unroll
                for (int m = 0; m < 4; ++m) { const int row = rowb + ai * HALF + m * 16; float ss = 0.f;
#pragma unroll
                    for (int bj = 0; bj < 2; ++bj)
#pragma unroll
                        for (int n = 0; n < 2; ++n) { const f32x4 x = ACCS(ai, bj, m, n); ss += (x[0] * x[0] + x[1] * x[1]) + (x[2] * x[2] + x[3] * x[3]); }
                    ss = xsum32(xsum16(ss));
                    float rs = __builtin_amdgcn_rsqf(ss * (1.0f / 64.0f) + 1e-6f); if (isq) rs *= 0.125f;
#pragma unroll
                    for (int bj = 0; bj < 2; ++bj) { const f32x4 v0 = ACCS(ai, bj, m, 0) * gv[bj][0] * rs, v1 = ACCS(ai, bj, m, 1) * gv[bj][1] * rs; const int col = head * 64 + 32 * bj + 8 * fq;
                        if (isq) *(u32x4*)(Qb + (size_t)row * 1024 + col) = pack8(v0, v1);
                        else { float* kp = (prompt ? Kp + (size_t)row * 1024 : Ks + (size_t)(row - MP) * 1024) + col; *(f32x4*)kp = v0; *(f32x4*)(kp + 4) = v1; } } }
        } else if (pn < 12) {
#pragma unroll
            for (int ai = 0; ai < 2; ++ai)
#pragma unroll
                for (int m = 0; m < 4; ++m) { const int row = rowb + ai * HALF + m * 16;
#pragma unroll
                    for (int bj = 0; bj < 2; ++bj) { const int col = (pn - 8) * 256 + bj * HALF + wc * 32 + 8 * fq; float* vp = (prompt ? Vp + (size_t)row * 1024 : Vs + (size_t)(row - MP) * 1024) + col;
                        *(f32x4*)vp = ACCS(ai, bj, m, 0); *(f32x4*)(vp + 4) = ACCS(ai, bj, m, 1); } }
        } else if (pn < 26) {
#pragma unroll
            for (int ai = 0; ai < 2; ++ai)
#pragma unroll
                for (int m = 0; m < 4; ++m) { const int row = rowb + ai * HALF + m * 16;
                    const bool last = prompt ? ((row & 8191) == 8191) : ((row & 63) == 63);
#pragma unroll
                    for (int bj = 0; bj < 2; ++bj) { const int col = (pn - 12) * 256 + bj * HALF + wc * 32 + 8 * fq;
                        *(u32x4*)(PRW + (size_t)row * 3584 + col) = pack8(ACCS(ai, bj, m, 0), ACCS(ai, bj, m, 1));
                        if (last && col < 3520) { float* sp = (prompt ? SHp + (size_t)(row >> 13) * 3520 : SHs + (size_t)((row - MP) >> 6) * 3520) + col; *(f32x4*)sp = ACCS(ai, bj, m, 0); *(f32x4*)(sp + 4) = ACCS(ai, bj, m, 1); } } }
        } else {
            unsigned char* G = pn < 34 ? GSB : GRW; const int t0 = pn < 34 ? 26 : 34;
#pragma unroll
            for (int ai = 0; ai < 2; ++ai)
#pragma unroll
                for (int m = 0; m < 4; ++m) { const int row = rowb + ai * HALF + m * 16;
#pragma unroll
                    for (int bj = 0; bj < 2; ++bj) { const int col = (pn - t0) * 256 + bj * HALF + wc * 32 + 8 * fq;
                        const f32x4 s0 = sigm4(ACCS(ai, bj, m, 0)) * 255.0f + 0.5f, s1 = sigm4(ACCS(ai, bj, m, 1)) * 255.0f + 0.5f;
                        u32x2 w; w.x = (unsigned)s0[0] | ((unsigned)s0[1] << 8) | ((unsigned)s0[2] << 16) | ((unsigned)s0[3] << 24); w.y = (unsigned)s1[0] | ((unsigned)s1[1] << 8) | ((unsigned)s1[2] << 16) | ((unsigned)s1[3] << 24);
                        *(u32x2*)(G + (size_t)row * 2048 + col) = w; } }
        }
    }
};
#undef ACCS
struct EpiLora {
    static constexpr bool PERM = true, AFTER_DRAIN = false;
    bf16_t* WD; bf16_t* KP; bf16_t* KKN; bf16_t* BV; bf16_t* G; const bf16_t* PRW; const float* muk; const float* shk; const float* w0; const float* a0; const float* k_k; const float* k_a;
    __device__ __forceinline__ void operator()(const f32x4 (&acc)[2][2][4][2], const Unit& u, int wr, int wc, int fr, int fq) const {
        const int pn = u.pn, type = pn >> 2, head = 4 * (pn & 3) + wc, rowb = u.pm * BM + wr * 64 + fr, colh = head * 64 + 8 * fq;
        if (type == 0) {
            f32x4 wv[2][2];
#pragma unroll
            for (int bj = 0; bj < 2; ++bj)
#pragma unroll
                for (int n = 0; n < 2; ++n) wv[bj][n] = *(const f32x4*)(w0 + colh + 32 * bj + 4 * n);
#pragma unroll
            for (int ai = 0; ai < 2; ++ai)
#pragma unroll
                for (int m = 0; m < 4; ++m) { const int row = rowb + ai * HALF + m * 16;
#pragma unroll
                    for (int bj = 0; bj < 2; ++bj) { f32x4 d[2];
#pragma unroll
                        for (int n = 0; n < 2; ++n) { const f32x4 x = acc[ai][bj][m][n] + wv[bj][n];
#pragma unroll
                            for (int e = 0; e < 4; ++e) { const float nx = -x[e]; const float sp = fmaxf(nx, 0.f) + __logf(1.0f + __expf(-fabsf(nx))); d[n][e] = __expf(-sp - 0.5f); } }
                        *(u32x4*)(WD + (size_t)row * 1024 + colh + 32 * bj) = pack8(d[0], d[1]); } }
        } else if (type == 1) {
#pragma unroll
            for (int ai = 0; ai < 2; ++ai)
#pragma unroll
                for (int m = 0; m < 4; ++m) { const int row = rowb + ai * HALF + m * 16; f32x4 al[2][2], kk[2][2]; float ss = 0.f;
                    asm volatile("" ::: "memory");
#pragma unroll
                    for (int bj = 0; bj < 2; ++bj) { f32x4 xk[2], pq[2]; const int cc0 = colh + 32 * bj;
                        unpack8(*(const u32x4*)(PRW + (size_t)row * 3584 + 1024 + cc0), xk[0], xk[1]);
                        const bool prompt = row < MP; const int tt = prompt ? (row & 8191) : ((row - MP) & 63);
                        if (tt != 0) unpack8(*(const u32x4*)(PRW + (size_t)(row - 1) * 3584 + 1024 + cc0), pq[0], pq[1]);
                        else if (prompt) { pq[0] = (f32x4){0.f, 0.f, 0.f, 0.f}; pq[1] = pq[0]; }
                        else { const float* sp = shk + (size_t)((row - MP) >> 6) * 3520 + cc0; pq[0] = *(const f32x4*)sp; pq[1] = *(const f32x4*)(sp + 4); }
                        xk[0] += (pq[0] - xk[0]) * *(const f32x4*)(muk + cc0); xk[1] += (pq[1] - xk[1]) * *(const f32x4*)(muk + cc0 + 4);
                        f32x4 kp[2];
#pragma unroll
                        for (int n = 0; n < 2; ++n) { const int cc = colh + 32 * bj + 4 * n;
                            al[bj][n] = sigm4(acc[ai][bj][m][n] + *(const f32x4*)(a0 + cc)); kk[bj][n] = xk[n] * *(const f32x4*)(k_k + cc); kp[n] = xk[n] * (1.0f + (al[bj][n] - 1.0f) * *(const f32x4*)(k_a + cc));
                            const f32x4 q = kk[bj][n]; ss += (q[0] * q[0] + q[1] * q[1]) + (q[2] * q[2] + q[3] * q[3]); }
                        *(u32x4*)(KP + (size_t)row * 1024 + colh + 32 * bj) = pack8(kp[0], kp[1]); }
                    ss = xsum32(xsum16(ss));
                    const float inv = __builtin_amdgcn_rsqf(fmaxf(ss, 1e-24f));
#pragma unroll
                    for (int bj = 0; bj < 2; ++bj) { const size_t off = (size_t)row * 1024 + colh + 32 * bj; const f32x4 n0 = kk[bj][0] * inv, n1 = kk[bj][1] * inv;
                        *(u32x4*)(KKN + off) = pack8(n0, n1); *(u32x4*)(BV + off) = pack8(n0 * al[bj][0], n1 * al[bj][1]); } }
        } else {
#pragma unroll
            for (int ai = 0; ai < 2; ++ai)
#pragma unroll
                for (int m = 0; m < 4; ++m) { const int row = rowb + ai * HALF + m * 16;
#pragma unroll
                    for (int bj = 0; bj < 2; ++bj) *(u32x4*)(G + (size_t)row * 1024 + colh + 32 * bj) = pack8(acc[ai][bj][m][0], acc[ai][bj][m][1]); }
        }
    }
};
template <int STEP> struct EpiMerge {
    static constexpr bool PERM = true, AFTER_DRAIN = false;
    const unsigned char* GATE; bf16_t* MPART; bf16_t* MERGED;
    __device__ __forceinline__ void operator()(const f32x4 (&acc)[2][2][4][2], const Unit& u, int wr, int wc, int fr, int fq) const {
        const int row0 = u.pm * BM + wr * 64 + fr, col0 = u.pn * BM + wc * 32 + 8 * fq;
#pragma unroll
        for (int ai = 0; ai < 2; ++ai) { u32x2 gw[4][2]; u32x4 mp[4][2];
#pragma unroll
            for (int m = 0; m < 4; ++m) { const size_t off = (size_t)(row0 + ai * HALF + m * 16) * 2048 + col0;
#pragma unroll
                for (int bj = 0; bj < 2; ++bj) { gw[m][bj] = *(const u32x2*)(GATE + off + bj * HALF); if (STEP == 2) mp[m][bj] = *(const u32x4*)(MPART + off + bj * HALF); } }
#pragma unroll
            for (int m = 0; m < 4; ++m) { const size_t off = (size_t)(row0 + ai * HALF + m * 16) * 2048 + col0;
#pragma unroll
                for (int bj = 0; bj < 2; ++bj) { const unsigned wa = gw[m][bj].x, wb = gw[m][bj].y;
                    const f32x4 g0 = (f32x4){(float)(wa & 0xffu), (float)((wa >> 8) & 0xffu), (float)((wa >> 16) & 0xffu), (float)(wa >> 24)} * (1.0f / 255.0f),
                                g1 = (f32x4){(float)(wb & 0xffu), (float)((wb >> 8) & 0xffu), (float)((wb >> 16) & 0xffu), (float)(wb >> 24)} * (1.0f / 255.0f);
                    f32x4 v0 = g0 * acc[ai][bj][m][0], v1 = g1 * acc[ai][bj][m][1];
                    if (STEP == 1) *(u32x4*)(MPART + off + bj * HALF) = pack8(v0, v1);
                    else { f32x4 p0, p1; unpack8(mp[m][bj], p0, p1); v0 += p0; v1 += p1; *(u32x4*)(MERGED + off + bj * HALF) = pack8(v0, v1); } } }
            asm volatile("" ::: "memory"); }
    }
};

template <class Epi, class Sched, bool ALIGN_EPI = false, bool SP2 = false, bool TILED = false>
__device__ __forceinline__ void gemm_phase(PG8_LAS unsigned char* lds, const Gemm g, const Sched& S, const Epi& E) {
    const int tid = threadIdx.x, wid = __builtin_amdgcn_readfirstlane(tid >> 6), lane = tid & 63, wr = wid >> 2, wc = wid & 3, fr = lane & 15, fq = lane >> 4;
    const int K = g.K;
    unsigned voffA[2], voffB[2];
#pragma unroll
    for (int i = 0; i < 2; ++i) { int R, C; stage_rc(tid * 16 + i * 8192, R, C); const int Rb = Epi::PERM ? ((R & ~31) + perm32(R & 31)) : R;
        voffA[i] = (unsigned)(R * (TILED ? 64 : K) + C) * 2u; voffB[i] = (unsigned)(Rb * (TILED ? 64 : K) + C) * 2u; }
    const size_t kstepA = TILED ? (size_t)g.M * 128 : (size_t)(BK * 2), kstepB = TILED ? (size_t)g.N * 128 : (size_t)(BK * 2);
    const size_t hstepA = (size_t)HALF * (TILED ? 64 : K) * 2, hstepB = hstepA;
    const size_t tstepA = 2 * hstepA, tstepB = 2 * hstepB;
    const unsigned ldsw = (unsigned)wid * 1024u;
    const int aoff = lds_byte(wr * 64 + fr, fq * 8), boff = lds_byte(wc * 32 + fr, fq * 8);
#define PG8_SA(b, h) (((b) * 2 + (h)) * HTB)
#define PG8_SB(b, h) ((4 + (b) * 2 + (h)) * HTB)
#define PG8_STAGE(bufoff, gbase, voff) do { _Pragma("unroll") for (int _i = 0; _i < 2; ++_i) \
        __builtin_amdgcn_global_load_lds((const unsigned*)((const char*)(gbase) + (voff)[_i]), (PG8_LAS unsigned*)(lds + (bufoff) + ldsw + _i * 8192), 16, 0, 0); } while (0)
#define PG8_LDA(dst, b, h) do { _Pragma("unroll") for (int m = 0; m < 4; ++m) _Pragma("unroll") for (int k = 0; k < 2; ++k) dst[m][k] = *(const PG8_LAS bf16x8*)(lds + PG8_SA(b, h) + aoff + m * 2048 + k * 1024); } while (0)
#define PG8_LDB(dst, b, h) do { _Pragma("unroll") for (int n = 0; n < 2; ++n) _Pragma("unroll") for (int k = 0; k < 2; ++k) dst[n][k] = *(const PG8_LAS bf16x8*)(lds + PG8_SB(b, h) + boff + n * 2048 + k * 1024); } while (0)
#define PG8_MMA(ai, bj, At, Bt) do { __builtin_amdgcn_s_setprio(1); _Pragma("unroll") for (int m = 0; m < 4; ++m) _Pragma("unroll") for (int n = 0; n < 2; ++n) _Pragma("unroll") for (int k = 0; k < 2; ++k) \
        acc[ai][bj][m][n] = __builtin_amdgcn_mfma_f32_16x16x32_bf16(Bt[n][k], At[m][k], acc[ai][bj][m][n], 0, 0, 0); __builtin_amdgcn_s_setprio(0); } while (0)
#define PG8_WAIT_V(n) asm volatile("s_waitcnt vmcnt(" #n ")" ::: "memory")
#define PG8_WAIT_L(n) asm volatile("s_waitcnt lgkmcnt(" #n ")" ::: "memory")
#define PG8_BAR __builtin_amdgcn_s_barrier()
#define PG8_SCHED __builtin_amdgcn_sched_barrier(0)
    Unit cur, nxt; int ui = 0;
    if (!S.next(0, cur)) return;
    f32x4 acc[2][2][4][2];
#pragma unroll
    for (int a = 0; a < 2; ++a)
#pragma unroll
        for (int b = 0; b < 2; ++b)
#pragma unroll
            for (int m = 0; m < 4; ++m)
#pragma unroll
                for (int n = 0; n < 2; ++n) acc[a][b][m][n] = (f32x4){0.f, 0.f, 0.f, 0.f};
    bf16x8 At[4][2], B0[2][2], B1[2][2];
    const char* cA = (const char*)g.A + (size_t)cur.pm * tstepA + (size_t)cur.kt0 * kstepA; const char* cB = (const char*)g.Bt + (size_t)cur.pn * tstepB + (size_t)cur.kt0 * kstepB;
    S.a_ready(cur, 0);
    if constexpr (SP2) {
        PG8_STAGE(PG8_SB(0, 0), cB, voffB); PG8_STAGE(PG8_SB(0, 1), cB + hstepB, voffB); PG8_STAGE(PG8_SA(0, 0), cA, voffA); PG8_STAGE(PG8_SA(0, 1), cA + hstepA, voffA);
        if (wr == 1) PG8_BAR;
        PG8_WAIT_V(2); PG8_BAR;
        PG8_STAGE(PG8_SB(1, 0), cB + kstepB, voffB); PG8_STAGE(PG8_SA(1, 0), cA + kstepA, voffA); PG8_STAGE(PG8_SB(1, 1), cB + hstepB + kstepB, voffB);
        PG8_WAIT_V(6); PG8_BAR;
    } else {
        PG8_STAGE(PG8_SB(0, 0), cB, voffB); PG8_STAGE(PG8_SA(0, 0), cA, voffA); PG8_STAGE(PG8_SB(0, 1), cB + hstepB, voffB); PG8_STAGE(PG8_SA(0, 1), cA + hstepA, voffA);
        if (wr == 1) PG8_BAR;
        PG8_WAIT_V(4); PG8_BAR;
        PG8_STAGE(PG8_SB(1, 0), cB + kstepB, voffB); PG8_STAGE(PG8_SA(1, 0), cA + kstepA, voffA); PG8_STAGE(PG8_SB(1, 1), cB + hstepB + kstepB, voffB);
        PG8_WAIT_V(6); PG8_BAR;
    }
    for (;;) {
        const bool has_next = S.next(ui + 1, nxt);
        const char* nA = has_next ? (const char*)g.A + (size_t)nxt.pm * tstepA + (size_t)nxt.kt0 * kstepA : cA; const char* nB = has_next ? (const char*)g.Bt + (size_t)nxt.pn * tstepB + (size_t)nxt.kt0 * kstepB : cB;
        const int nt = cur.nkt;
        for (int t = 0; t < nt; t += 2) {
            const bool last = (t == nt - 2);
            const char* a1 = cA + (size_t)(t + 1) * kstepA;
            const char* a2 = last ? nA : cA + (size_t)(t + 2) * kstepA; const char* b2 = last ? nB : cB + (size_t)(t + 2) * kstepB;
            const char* a3 = a2 + kstepA; const char* b3 = b2 + kstepB;
            if (last && has_next) S.a_ready(nxt, ui + 1);
            if constexpr (SP2) {
            PG8_LDB(B0, 0, 0); PG8_LDB(B1, 0, 1); PG8_SCHED; PG8_LDA(At, 0, 0); PG8_STAGE(PG8_SA(1, 1), a1 + hstepA, voffA);
            PG8_WAIT_V(8); PG8_WAIT_L(0); PG8_BAR; PG8_MMA(0, 0, At, B0); PG8_MMA(0, 1, At, B1); PG8_BAR; PG8_SCHED;
            PG8_LDA(At, 0, 1); PG8_STAGE(PG8_SB(0, 0), b2, voffB); PG8_STAGE(PG8_SB(0, 1), b2 + hstepB, voffB); PG8_STAGE(PG8_SA(0, 0), a2, voffA);
            PG8_WAIT_V(8); PG8_WAIT_L(0); PG8_BAR; PG8_MMA(1, 0, At, B0); PG8_MMA(1, 1, At, B1); PG8_BAR; PG8_SCHED;
            PG8_LDB(B0, 1, 0); PG8_LDB(B1, 1, 1); PG8_SCHED; PG8_LDA(At, 1, 0); PG8_STAGE(PG8_SA(0, 1), a2 + hstepA, voffA);
            PG8_WAIT_V(8); PG8_WAIT_L(0); PG8_BAR; PG8_MMA(0, 0, At, B0); PG8_MMA(0, 1, At, B1); PG8_BAR; PG8_SCHED;
            PG8_LDA(At, 1, 1); PG8_STAGE(PG8_SB(1, 0), b3, voffB); PG8_STAGE(PG8_SB(1, 1), b3 + hstepB, voffB); PG8_STAGE(PG8_SA(1, 0), a3, voffA);
            PG8_WAIT_V(8); PG8_WAIT_L(0); PG8_BAR; PG8_MMA(1, 0, At, B0); PG8_MMA(1, 1, At, B1); PG8_BAR; PG8_SCHED;
            } else {
            PG8_LDB(B0, 0, 0); PG8_SCHED; PG8_LDA(At, 0, 0); PG8_STAGE(PG8_SA(1, 1), a1 + hstepA, voffA);
            PG8_WAIT_L(8); PG8_BAR; PG8_WAIT_L(0); PG8_MMA(0, 0, At, B0); PG8_BAR; PG8_SCHED;
            PG8_LDB(B1, 0, 1); PG8_STAGE(PG8_SB(0, 0), b2, voffB);
            PG8_BAR; PG8_WAIT_L(0); PG8_MMA(0, 1, At, B1); PG8_BAR;
            PG8_LDA(At, 0, 1); PG8_STAGE(PG8_SA(0, 0), a2, voffA);
            PG8_BAR; PG8_WAIT_L(0); PG8_MMA(1, 0, At, B0); PG8_BAR; PG8_SCHED;
            PG8_STAGE(PG8_SB(0, 1), b2 + hstepB, voffB);
            PG8_WAIT_V(6); PG8_BAR; PG8_MMA(1, 1, At, B1); PG8_BAR;
            PG8_LDB(B0, 1, 0); PG8_SCHED; PG8_LDA(At, 1, 0); PG8_STAGE(PG8_SA(0, 1), a2 + hstepA, voffA);
            PG8_WAIT_L(8); PG8_BAR; PG8_WAIT_L(0); PG8_MMA(0, 0, At, B0); PG8_BAR; PG8_SCHED;
            PG8_LDB(B1, 1, 1); PG8_STAGE(PG8_SB(1, 0), b3, voffB);
            PG8_BAR; PG8_WAIT_L(0); PG8_MMA(0, 1, At, B1); PG8_BAR;
            PG8_LDA(At, 1, 1); PG8_STAGE(PG8_SA(1, 0), a3, voffA);
            PG8_BAR; PG8_WAIT_L(0); PG8_MMA(1, 0, At, B0); PG8_BAR; PG8_SCHED;
            PG8_STAGE(PG8_SB(1, 1), b3 + hstepB, voffB);
            PG8_WAIT_V(6); PG8_BAR; PG8_MMA(1, 1, At, B1); PG8_BAR;
            }
        }
        if constexpr (ALIGN_EPI) { if (wr == 0) PG8_BAR; }
        if constexpr (!Epi::AFTER_DRAIN) { E(acc, cur, wr, wc, fr, fq); S.done(cur, ui); }
        if (!has_next) break;
#pragma unroll
        for (int a = 0; a < 2; ++a)
#pragma unroll
            for (int b = 0; b < 2; ++b)
#pragma unroll
                for (int m = 0; m < 4; ++m)
#pragma unroll
                    for (int n = 0; n < 2; ++n) acc[a][b][m][n] = (f32x4){0.f, 0.f, 0.f, 0.f};
        cur = nxt; cA = nA; cB = nB; ++ui;
        if constexpr (ALIGN_EPI) { if (wr == 1) PG8_BAR; }
    }
    PG8_WAIT_V(0);
    if constexpr (!ALIGN_EPI) { if (wr == 0) PG8_BAR; }
    PG8_BAR;
    if constexpr (Epi::AFTER_DRAIN) { E.fused(acc, cur, wr, wc, fr, fq, lds, wid, lane); S.done(cur, ui); }
#undef PG8_SA
#undef PG8_SB
#undef PG8_STAGE
#undef PG8_LDA
#undef PG8_LDB
#undef PG8_MMA
#undef PG8_WAIT_V
#undef PG8_WAIT_L
#undef PG8_BAR
#undef PG8_SCHED
}
}
#define GAS __attribute__((address_space(1)))
#define LAS __attribute__((address_space(3)))
typedef unsigned short bf16;
typedef unsigned v4u __attribute__((ext_vector_type(4)));
typedef float f32x4 __attribute__((ext_vector_type(4)));
typedef short bf16x8 __attribute__((ext_vector_type(8)));
typedef GAS unsigned gu32;
typedef GAS unsigned long long gu64;
#define RLX_AGENT __ATOMIC_RELAXED, __HIP_MEMORY_SCOPE_AGENT
#define LDS_WAIT() asm volatile("s_waitcnt lgkmcnt(0)" ::: "memory")
#define VM_WAIT() asm volatile("s_waitcnt vmcnt(0)" ::: "memory")
__device__ __forceinline__ unsigned long long rt() { return __builtin_amdgcn_s_memrealtime(); }
__device__ __forceinline__ unsigned f2bf(float f) { unsigned u = __builtin_bit_cast(unsigned, f); return (u + 0x7fffu + ((u >> 16) & 1u)) >> 16; }
__device__ __forceinline__ unsigned pk2(float lo, float hi) { return f2bf(lo) | (f2bf(hi) << 16); }

#define XB_TMO      128
#define XB_XCNT(j)  (256  + 64 * (j))
#define XB_XSUB(j)  (1280 + 64 * (j))
#define XB_XGEN(j)  (2304 + 64 * (j))
#define XB_TOP      3328
#define XB_TOPGEN   3392
#define XCD_BAR_WORDS 3456
#define XB_SPIN_CAP (1u << 18)

__device__ __forceinline__ unsigned xb_ld(unsigned* p)              { return __hip_atomic_load(p, __ATOMIC_RELAXED, __HIP_MEMORY_SCOPE_AGENT); }
__device__ __forceinline__ unsigned xb_add(unsigned* p, unsigned v) { return __hip_atomic_fetch_add(p, v, __ATOMIC_RELAXED, __HIP_MEMORY_SCOPE_AGENT); }
__device__ __forceinline__ unsigned xb_xcc_id() { return (unsigned)__builtin_amdgcn_s_getreg((3 << 11) | 20) & 0xFu; }
#define XB_SPIN(cond, bar) do { unsigned _sp = 0; while (cond) { __builtin_amdgcn_s_sleep(1); \
    if ((++_sp & 255u) == 0u) { if (xb_ld(&(bar)[XB_TMO])) break; if (_sp > XB_SPIN_CAP) { atomicAdd(&(bar)[XB_TMO], 1u); break; } } } } while (0)

struct XcdBarrier {
    unsigned* bar; unsigned x;
    volatile LAS unsigned* st;
};

__device__ __forceinline__ XcdBarrier xcd_barrier_post(unsigned* bar, volatile LAS unsigned* st) {
    XcdBarrier b; b.bar = bar; b.x = xb_xcc_id(); b.st = st;
    if (threadIdx.x == 0) (void)xb_add(&bar[XB_XCNT(b.x)], 1u);
    return b;
}
__device__ __forceinline__ void xcd_barrier_complete(unsigned* bar, unsigned x, unsigned& nloc, unsigned& nx) {
    const unsigned G = gridDim.x * gridDim.y * gridDim.z;
    unsigned sum, cnt, mine, sp = 0u;
    for (;;) {
        sum = 0u; cnt = 0u; mine = 0u;
#pragma unroll
        for (unsigned j = 0; j < 16; ++j) { const unsigned c = xb_ld(&bar[XB_XCNT(j)]); sum += c; cnt += (c > 0u) ? 1u : 0u; mine = (j == x) ? c : mine; }
        if (sum == G) break;
        __builtin_amdgcn_s_sleep(1);
        if ((++sp & 255u) == 0u) { if (xb_ld(&bar[XB_TMO])) break; if (sp > XB_SPIN_CAP) { atomicAdd(&bar[XB_TMO], 1u); break; } }
    }
    nloc = mine > 0u ? mine : 1u; nx = cnt > 0u ? cnt : 1u;
}

__device__ __forceinline__ void xcd_barrier(const XcdBarrier& b) {
    asm volatile("s_waitcnt vmcnt(0)" ::: "memory");
    __syncthreads();
    if (threadIdx.x == 0) {
        unsigned* bar = b.bar;
        __builtin_amdgcn_s_waitcnt(0);
        unsigned nloc = b.st[0], nx = b.st[1];
        if (nloc == 0u) { xcd_barrier_complete(bar, b.x, nloc, nx); b.st[0] = nloc; b.st[1] = nx; }
        const unsigned old = xb_add(&bar[XB_XSUB(b.x)], 1u);
        const unsigned gen = old / nloc;
        if (old + 1u == (gen + 1u) * nloc) {
            __builtin_amdgcn_fence(__ATOMIC_RELEASE, "agent");
            asm volatile("s_waitcnt vmcnt(0)" ::: "memory");
            const unsigned og = xb_add(&bar[XB_TOP], 1u);
            const unsigned tg = og / nx;
            if (og + 1u == (tg + 1u) * nx) xb_add(&bar[XB_TOPGEN], 1u);
            else XB_SPIN(xb_ld(&bar[XB_TOPGEN]) == tg, bar);
            __builtin_amdgcn_fence(__ATOMIC_ACQUIRE, "agent");
            xb_add(&bar[XB_XGEN(b.x)], 1u);
            asm volatile("s_waitcnt vmcnt(0)" ::: "memory");
        } else {
            XB_SPIN(xb_ld(&bar[XB_XGEN(b.x)]) == gen, bar);
            __builtin_amdgcn_fence(__ATOMIC_ACQUIRE, "agent");
            asm volatile("s_waitcnt vmcnt(0)" ::: "memory");
        }
    }
    __syncthreads();
}
constexpr int NWAVES = 8;
constexpr int DM = 2048, DFF = 5632, SBW = 1024, RWW = 1024, RWC = 3520, RWCP = 3584;
constexpr int TP = 8192, NBP = 2, TS = 64, NBS = 32, PAST = 4096;
constexpr int MPROMPT = NBP * TP, MSAMPLE = NBS * TS, M = MPROMPT + MSAMPLE;
constexpr int NGU = 2 * DFF;
constexpr int NWIN = 42 * 256;
constexpr int KLORA = 512, NLORA = 3072;
constexpr int CH = 256, NCH = TP / CH;
static_assert(M % 256 == 0 && MPROMPT % 256 == 0 && pg8::MP == MPROMPT, "row panels");
constexpr size_t O_Y = 0, O_KP = (size_t)M * DM, O_VP = O_KP + (size_t)MPROMPT * SBW, O_WKVP = O_VP + (size_t)MPROMPT * SBW, O_SHP = O_WKVP + (size_t)NBP * 16 * 4096,
                 O_KS = O_SHP + (size_t)NBP * RWC, O_VS = O_KS + (size_t)MSAMPLE * SBW, O_WKVS = O_VS + (size_t)MSAMPLE * SBW, O_SHS = O_WKVS + (size_t)NBS * 16 * 4096, O_END = O_SHS + (size_t)NBS * RWC;
static_assert(O_END == 77845376, "output size");
constexpr size_t MiB = 1u << 20;
constexpr size_t al256(size_t x) { return (x + 255) & ~(size_t)255; }
constexpr size_t WS_CTL = 0, CTL_ZERO_BYTES = 1 * MiB;
constexpr size_t WS_W1GU = 1 * MiB;
constexpr size_t WS_W1D  = WS_W1GU + (size_t)NGU * DM * 2;
constexpr size_t WS_W2GU = WS_W1D + (size_t)DM * DFF * 2;
constexpr size_t WS_W2D  = WS_W2GU + (size_t)NGU * DM * 2;
constexpr size_t WS_WIN  = WS_W2D + (size_t)DM * DFF * 2;
constexpr size_t WS_WSBO = WS_WIN + (size_t)NWIN * DM * 2;
constexpr size_t WS_WRWO = WS_WSBO + (size_t)DM * SBW * 2;
constexpr size_t WS_WOUT = WS_WRWO + (size_t)DM * RWW * 2;
constexpr size_t WS_WLORA = WS_WOUT + (size_t)DM * DM * 2;
constexpr size_t WS_XN   = al256(WS_WLORA + (size_t)NLORA * KLORA * 2);
constexpr size_t WS_H    = WS_XN + (size_t)M * DM * 2;
constexpr size_t WS_HRES = WS_H + (size_t)M * DFF * 2;
constexpr size_t WS_QB   = WS_HRES + (size_t)M * DM * 4;
constexpr size_t WS_PRW  = WS_QB + (size_t)M * SBW * 2;
constexpr size_t WS_GSB  = WS_PRW + (size_t)M * RWCP * 2;
constexpr size_t WS_GRW  = WS_GSB + (size_t)M * DM * 2;
constexpr size_t WS_AO   = WS_GRW + (size_t)M * DM * 2;
constexpr size_t WS_XR   = WS_AO + (size_t)M * SBW * 2;
constexpr size_t WS_XK   = WS_XR + (size_t)M * RWW * 2;
constexpr size_t WS_XV   = WS_XK + (size_t)M * RWW * 2;
constexpr size_t WS_ACAT = WS_XV + (size_t)M * RWW * 2;
constexpr size_t WS_WD   = WS_ACAT + (size_t)M * KLORA * 2;
constexpr size_t WS_KP   = WS_WD + (size_t)M * RWW * 4;
constexpr size_t WS_KKN  = WS_KP + (size_t)M * RWW * 2;
constexpr size_t WS_BV   = WS_KKN + (size_t)M * RWW * 2;
constexpr size_t WS_G    = WS_BV + (size_t)M * RWW * 2;
constexpr size_t WS_YRW  = WS_G + (size_t)M * RWW * 2;
constexpr size_t WS_PC   = WS_YRW + (size_t)M * RWW * 2;
constexpr size_t WS_UC   = WS_PC + (size_t)32 * NCH * 4096 * 4;
constexpr size_t WS_SC   = WS_UC + (size_t)32 * NCH * 4096 * 4;
constexpr size_t WS_PART = WS_SC + (size_t)32 * NCH * 4096 * 4;
constexpr size_t WS_END  = WS_PART + (size_t)64 * 4 * 65536 * 4;
static_assert((size_t)M * DM * 4 <= (size_t)M * DFF * 2, "MPART fits in H");
constexpr int CW_BAR = 4096, CW_ATTQ = 8192, CW_SS1 = 16384, CW_SS2 = 40960, CW_SS0 = 61440, CW_MFLAG = 100000;
static_assert(CW_SS1 + M <= CW_SS2 && CW_SS2 + M <= CW_SS0 && (size_t)(CW_SS0 + M) * 4 <= CTL_ZERO_BYTES, "row statistics inside the zeroed control region");
constexpr int RING_OFF = 0, RING_BYTES = 131072;
constexpr int LDSCTL_OFF = RING_BYTES, MISC_OFF = LDSCTL_OFF + 320;
constexpr int ATT2_OFF = LDSCTL_OFF + 512;
constexpr int LDS_BYTES = 151552;
static_assert(MISC_OFF + 128 <= ATT2_OFF && ATT2_OFF + 4 * 4608 <= LDS_BYTES && LDS_BYTES <= 160 * 1024 && pg8::STAGE_BYTES <= RING_BYTES, "LDS map");

struct Params {
    const float* in[32]; float* out; unsigned char* ws; int ph_lo, ph_hi;
};
typedef float f32x16 __attribute__((ext_vector_type(16)));
using pg8::u32x2;
__device__ __forceinline__ unsigned cvtpk(float lo, float hi) { return pg8::cvt_pk_bf16(lo, hi); }
__device__ __forceinline__ float bf_lo(unsigned w) { return __uint_as_float(w << 16); }
__device__ __forceinline__ float bf_hi(unsigned w) { return __uint_as_float(w & 0xffff0000u); }

template <int CTRL> __device__ __forceinline__ float dppf(float x) { return __builtin_bit_cast(float, __builtin_amdgcn_update_dpp(0, __builtin_bit_cast(int, x), CTRL, 0xf, 0xf, true)); }
__device__ __forceinline__ float red8(float x) {
    x += dppf<0xB1>(x);
    x += dppf<0x4E>(x);
    x += dppf<0x141>(x);
    return x;
}
using pg8::xsum16; using pg8::xsum32;
__device__ __forceinline__ float row16_sum(float x) {
    x = red8(x); x += dppf<0x128>(x); return x;
}
__device__ __forceinline__ float wave_sum(float x) { return xsum32(xsum16(row16_sum(x))); }
__device__ __forceinline__ float red_hi8(float x) {
    x += dppf<0x128>(x);
    return xsum32(xsum16(x));
}

__device__ __forceinline__ void p0_transpose_item(const float* W, int K, int N, bf16* WT, int vrow0, int k0, int n0, LAS float* scr, int lane, const float* kgain = nullptr, int tiledN = 0) {
    float tv[32];
#pragma unroll
    for (int i = 0; i < 32; ++i) tv[i] = W[(size_t)(k0 + 2 * i + (lane >> 5)) * N + n0 + (lane & 31)];
#pragma unroll
    for (int i = 0; i < 32; ++i) scr[(2 * i + (lane >> 5)) * 33 + (lane & 31)] = tv[i];
    LDS_WAIT(); asm volatile("" ::: "memory");
    const int c = lane & 7; f32x4 ga = (f32x4){1.f, 1.f, 1.f, 1.f}, gb = ga;
    if (kgain) { ga = *(const f32x4*)(kgain + k0 + 8 * c); gb = *(const f32x4*)(kgain + k0 + 8 * c + 4); }
#pragma unroll
    for (int j = 0; j < 4; ++j) { const int n = (lane >> 3) + 8 * j; const LAS float* s = scr + (8 * c) * 33 + n;
        v4u o; o.x = cvtpk(s[0 * 33] * ga[0], s[1 * 33] * ga[1]); o.y = cvtpk(s[2 * 33] * ga[2], s[3 * 33] * ga[3]); o.z = cvtpk(s[4 * 33] * gb[0], s[5 * 33] * gb[1]); o.w = cvtpk(s[6 * 33] * gb[2], s[7 * 33] * gb[3]);
        *(v4u*)(tiledN ? WT + ((size_t)(k0 >> 6) * tiledN + vrow0 + n) * 64 + 8 * c : WT + (size_t)(vrow0 + n) * K + k0 + 8 * c) = o; }
    LDS_WAIT(); asm volatile("" ::: "memory");
}
__device__ __forceinline__ int headperm_v(int w) { return 128 * ((w & 63) >> 5) + 32 * (w >> 6) + (w & 31); }
__device__ __forceinline__ int win_vrow(int n) {
    if (n < 2048) return (n & ~255) + headperm_v(n & 255);
    if (n < 6592) return n;
    return n + 64;
}
__device__ __forceinline__ void rms_row_to_bf16(const float* xrow, const float* gain, bf16* orow, int lane) {
    const f32x4* xr = (const f32x4*)xrow + lane; f32x4 v[8]; float s = 0.f;
#pragma unroll
    for (int j = 0; j < 8; ++j) { v[j] = xr[64 * j]; s += (v[j].x * v[j].x + v[j].y * v[j].y) + (v[j].z * v[j].z + v[j].w * v[j].w); }
    const float rs = __builtin_amdgcn_rsqf(wave_sum(s) * (1.0f / DM) + 1e-6f);
    u32x2* o8 = (u32x2*)orow + lane;
#pragma unroll
    for (int j = 0; j < 8; ++j) { const f32x4 g = *((const f32x4*)gain + lane + 64 * j); u32x2 w; w.x = cvtpk(v[j].x * rs * g.x, v[j].y * rs * g.y); w.y = cvtpk(v[j].z * rs * g.z, v[j].w * rs * g.w); o8[64 * j] = w; }
}
__device__ __forceinline__ void row_to_bf16_ss(const float* xrow, bf16* orow, float* ssp, int lane) {
    const f32x4* xr = (const f32x4*)xrow + lane; f32x4 v[8]; float s = 0.f;
#pragma unroll
    for (int j = 0; j < 8; ++j) { v[j] = xr[64 * j]; s += (v[j].x * v[j].x + v[j].y * v[j].y) + (v[j].z * v[j].z + v[j].w * v[j].w); }
    s = wave_sum(s); if (lane == 0) *ssp = s;
    u32x2* o8 = (u32x2*)orow + lane;
#pragma unroll
    for (int j = 0; j < 8; ++j) { u32x2 w; w.x = cvtpk(v[j].x, v[j].y); w.y = cvtpk(v[j].z, v[j].w); o8[64 * j] = w; }
}
__device__ __forceinline__ void p0_transpose_item32(const float* W, int K, int N, bf16* WT, int vrow0, int k0, int n0, LAS float* scr, int lane, const float* kgain) {
    float tv[16];
#pragma unroll
    for (int i = 0; i < 16; ++i) tv[i] = W[(size_t)(k0 + 2 * i + (lane >> 5)) * N + n0 + (lane & 31)];
#pragma unroll
    for (int i = 0; i < 16; ++i) scr[(2 * i + (lane >> 5)) * 33 + (lane & 31)] = tv[i];
    LDS_WAIT(); asm volatile("" ::: "memory");
    const int c = lane & 3; f32x4 ga = (f32x4){1.f, 1.f, 1.f, 1.f}, gb = ga;
    if (kgain) { ga = *(const f32x4*)(kgain + k0 + 8 * c); gb = *(const f32x4*)(kgain + k0 + 8 * c + 4); }
#pragma unroll
    for (int j = 0; j < 2; ++j) { const int n = (lane >> 2) + 16 * j; const LAS float* s = scr + (8 * c) * 33 + n;
        v4u o; o.x = cvtpk(s[0 * 33] * ga[0], s[1 * 33] * ga[1]); o.y = cvtpk(s[2 * 33] * ga[2], s[3 * 33] * ga[3]); o.z = cvtpk(s[4 * 33] * gb[0], s[5 * 33] * gb[1]); o.w = cvtpk(s[6 * 33] * gb[2], s[7 * 33] * gb[3]);
        *(v4u*)(WT + (size_t)(vrow0 + n) * K + k0 + 8 * c) = o; }
    LDS_WAIT(); asm volatile("" ::: "memory");
}
__device__ __forceinline__ void late_convert(const Params& p, LAS float* scr, int vw, int NVW, int lane) {
    unsigned char* ws = p.ws;
    constexpr int J_G = (DM / 32) * (DFF / 32), J_D = (DFF / 32) * (DM / 32), J_O = (SBW / 32) * (DM / 32), J_OUT = (DM / 32) * (DM / 32);
    constexpr int NJ = 2 * J_O + J_OUT + 2 * J_G + J_D;
    for (int it = vw; it < NJ; it += NVW) {
        int r = it;
        if (r < 2 * J_O) { const int which = r / J_O; r -= which * J_O; const int nblk = DM / 32, kb = r / nblk, nb = r % nblk;
            p0_transpose_item32(p.in[which ? 26 : 14], SBW, DM, (bf16*)(ws + (which ? WS_WRWO : WS_WSBO)), 32 * nb, 32 * kb, 32 * nb, scr, lane, nullptr); continue; }
        r -= 2 * J_O;
        if (r < J_OUT) { const int nblk = DM / 32, kb = r / nblk, nb = r % nblk; p0_transpose_item32(p.in[27], DM, DM, (bf16*)(ws + WS_WOUT), 32 * nb, 32 * kb, 32 * nb, scr, lane, nullptr); continue; }
        r -= J_OUT;
        if (r < 2 * J_G) { const int up = r / J_G; r -= up * J_G; const int nblk = DFF / 32, kb = r / nblk, nb = r % nblk, n0 = 32 * nb; const int vrow0 = 256 * (n0 >> 7) + (n0 & 127) + 128 * up;
            p0_transpose_item32(p.in[29 + up], DM, DFF, (bf16*)(ws + WS_W2GU), vrow0, 32 * kb, n0, scr, lane, p.in[28]); continue; }
        r -= 2 * J_G;
        { const int nblk = DM / 32, kb = r / nblk, nb = r % nblk; p0_transpose_item32(p.in[31], DFF, DM, (bf16*)(ws + WS_W2D), 32 * nb, 32 * kb, 32 * nb, scr, lane, nullptr); }
    }
}
__device__ __forceinline__ void conv_w1d(const Params& p, LAS float* scr, int vw, int NVW, int lane) {
    constexpr int I_D = (DFF / 64) * (DM / 32);
    for (int r = vw; r < I_D; r += NVW) { const int nblk = DM / 32, kb = r / nblk, nb = r % nblk; p0_transpose_item(p.in[9], DFF, DM, (bf16*)(p.ws + WS_W1D), 32 * nb, 64 * kb, 32 * nb, scr, lane); }
}
__device__ __forceinline__ void conv_win_lora(const Params& p, LAS float* scr, int vw, int NVW, int lane) {
    unsigned char* ws = p.ws;
    constexpr int I_IN = (DM / 64) * (10688 / 32);
    for (int r = vw; r < I_IN; r += NVW) { const int nblk = 10688 / 32, kb = r / nblk, nb = r % nblk, n0 = 32 * nb; p0_transpose_item(p.in[11], DM, 10688, (bf16*)(ws + WS_WIN), win_vrow(n0), 64 * kb, n0, scr, lane, p.in[10]); }
    { const int gt = vw * 64 + lane, NGT = NVW * 64; bf16* WT = (bf16*)(ws + WS_WIN) + (size_t)6592 * DM;
        for (int c = gt; c < 64 * DM / 8; c += NGT) *(v4u*)(WT + (size_t)c * 8) = (v4u){0u, 0u, 0u, 0u};
        bf16* WL = (bf16*)(ws + WS_WLORA);
        for (int c = gt; c < NLORA * (KLORA / 8); c += NGT) { const int vrow = c >> 6, kc = (c & 63) * 8; const int type = vrow >> 10, v = vrow & 255, tile = (vrow >> 8) & 3;
            const int ncol = tile * 256 + 64 * ((v >> 5) & 3) + 32 * (v >> 7) + (v & 31);
            const float* W = p.in[type == 0 ? 17 : (type == 1 ? 19 : 20)]; const int koff = type == 0 ? 0 : (type == 1 ? 128 : 256), kn = type == 2 ? 256 : 96;
            float f[8];
#pragma unroll
            for (int e = 0; e < 8; ++e) { const int k = kc + e - koff; f[e] = (k >= 0 && k < kn) ? W[(size_t)k * 1024 + ncol] : 0.f; }
            *(v4u*)(WL + (size_t)vrow * KLORA + kc) = (v4u){cvtpk(f[0], f[1]), cvtpk(f[2], f[3]), cvtpk(f[4], f[5]), cvtpk(f[6], f[7])}; } }
}
__device__ __forceinline__ void p0_prologue(const Params& p, LAS unsigned char* lds, int gw, int NGW, int wave, int lane) {
    LAS float* scr = (LAS float*)(lds + RING_OFF + wave * 16384);
    unsigned char* ws = p.ws;
    constexpr int I_G = (DM / 64) * (DFF / 32);
    for (int it = gw; it < 2 * I_G; it += NGW) { const int up = it / I_G, r = it - up * I_G;
        const int nblk = DFF / 32, kb = r / nblk, nb = r % nblk, n0 = 32 * nb; const int vrow0 = 256 * (n0 >> 7) + (n0 & 127) + 128 * up;
        p0_transpose_item(p.in[7 + up], DM, DFF, (bf16*)(ws + WS_W1GU), vrow0, 64 * kb, n0, scr, lane, p.in[6]); }
    for (int m = gw; m < M; m += NGW) { const float* xr = m < MPROMPT ? p.in[0] + (size_t)m * DM : p.in[1] + (size_t)(m - MPROMPT) * DM; row_to_bf16_ss(xr, (bf16*)(ws + WS_XN) + (size_t)m * DM, (float*)(ws + WS_CTL) + CW_SS0 + m, lane); }
}
typedef pg8::StaticOrderT<M, DM, DFF, true> TailSO;
static_assert(TailSO::TAIL_UNITS == 64 && TailSO::SF == 4 && pg8::StaticOrderT<M, DM, DM, true>::TAIL_UNITS == 64 && pg8::StaticOrderT<M, DM, DM, true>::SF == 4, "tail geometry");
__device__ __forceinline__ void rms_row_tail(bf16* hrow, const float* xrow, float scale, const float* PART, int tpm, int tpn, int m, const float* gain, bf16* orow, int lane) {
    u32x2* hr = (u32x2*)hrow + lane; f32x4 v[8]; float s = 0.f; const int pm = m >> 8, rl = m & 255;
#pragma unroll
    for (int j = 0; j < 8; ++j) {
        const unsigned long long bal = __ballot(tpm == pm && tpn == j);
        if (bal) { const int uu = __builtin_ctzll(bal); const float* pp = PART + (size_t)uu * 4 * 65536 + rl * 256 + 4 * lane;
            f32x4 a; if (xrow) a = *((const f32x4*)xrow + lane + 64 * j); else { const u32x2 w = hr[64 * j]; a = (f32x4){bf_lo(w.x), bf_hi(w.x), bf_lo(w.y), bf_hi(w.y)}; }
            a += (*(const f32x4*)pp + *(const f32x4*)(pp + 65536) + *(const f32x4*)(pp + 2 * 65536) + *(const f32x4*)(pp + 3 * 65536)) * scale;
            u32x2 w; w.x = cvtpk(a[0], a[1]); w.y = cvtpk(a[2], a[3]); hr[64 * j] = w; v[j] = (f32x4){bf_lo(w.x), bf_hi(w.x), bf_lo(w.y), bf_hi(w.y)}; }
        else { const u32x2 w = hr[64 * j]; v[j] = (f32x4){bf_lo(w.x), bf_hi(w.x), bf_lo(w.y), bf_hi(w.y)}; }
        s += (v[j].x * v[j].x + v[j].y * v[j].y) + (v[j].z * v[j].z + v[j].w * v[j].w); }
    const float rs = __builtin_amdgcn_rsqf(wave_sum(s) * (1.0f / DM) + 1e-6f);
    u32x2* o8 = (u32x2*)orow + lane;
#pragma unroll
    for (int j = 0; j < 8; ++j) { const f32x4 g = *((const f32x4*)gain + lane + 64 * j); u32x2 w; w.x = cvtpk(v[j].x * rs * g.x, v[j].y * rs * g.y); w.y = cvtpk(v[j].z * rs * g.z, v[j].w * rs * g.w); o8[64 * j] = w; }
}
__device__ __forceinline__ void norm_phase(bf16* H, const float* xb0, const float* xb1, float scale, const float* PART, const float* gain, bf16* XN, int gw, int NGW, int lane) {
    const int t = pg8::tile_of(TailSO::full * pg8::GRID + lane, TailSO::nM, TailSO::nN), tpm = t & 0xffff, tpn = t >> 16;
    for (int m = gw; m < M; m += NGW) { bf16* hrow = H + (size_t)m * DM; const float* xrow = xb0 ? (m < MPROMPT ? xb0 : xb1) + (size_t)m * DM : nullptr;
        rms_row_tail(hrow, xrow, scale, PART, tpm, tpn, m, gain, XN + (size_t)m * DM, lane); }
}
__device__ __forceinline__ f32x4 part4(const bf16* pp) {
    f32x4 s = (f32x4){0.f, 0.f, 0.f, 0.f};
#pragma unroll
    for (int q = 0; q < 4; ++q) { const u32x2 w = *(const u32x2*)(pp + (size_t)q * 65536); s += (f32x4){bf_lo(w.x), bf_hi(w.x), bf_lo(w.y), bf_hi(w.y)}; }
    return s;
}
__device__ __forceinline__ void tail_combine_h(const bf16* base, float scale, const float* PART, bf16* H, float* ss, int gw, int NGW, int lane) {
    for (int pc = gw; pc < TailSO::TAIL_UNITS * 256; pc += NGW) { const int uu = pc >> 8, rl = pc & 255; const int t = pg8::tile_of(TailSO::full * pg8::GRID + uu, TailSO::nM, TailSO::nN), pm = t & 0xffff, pn = t >> 16;
        const size_t off = (size_t)(pm * 256 + rl) * DM + pn * 256 + 4 * lane; const bf16* pp = (const bf16*)PART + (size_t)uu * 4 * 65536 + rl * 256 + 4 * lane;
        const u32x2 w = *(const u32x2*)(base + off); const f32x4 b = (f32x4){bf_lo(w.x), bf_hi(w.x), bf_lo(w.y), bf_hi(w.y)};
        const f32x4 v = b + part4(pp) * scale;
        u32x2 o; o.x = cvtpk(v[0], v[1]); o.y = cvtpk(v[2], v[3]); *(u32x2*)(H + off) = o;
        const float sq = wave_sum((v[0] * v[0] + v[1] * v[1]) + (v[2] * v[2] + v[3] * v[3]));
        if (lane == 0) unsafeAtomicAdd(ss + pm * 256 + rl, sq); }
}
__device__ __forceinline__ void tail_combine(const bf16* H, float scale, const float* PART, float* out, int gw, int NGW, int lane) {
    for (int pc = gw; pc < TailSO::TAIL_UNITS * 256; pc += NGW) { const int uu = pc >> 8, rl = pc & 255; const int t = pg8::tile_of(TailSO::full * pg8::GRID + uu, TailSO::nM, TailSO::nN), pm = t & 0xffff, pn = t >> 16;
        const size_t off = (size_t)(pm * 256 + rl) * DM + pn * 256 + 4 * lane; const bf16* pp = (const bf16*)PART + (size_t)uu * 4 * 65536 + rl * 256 + 4 * lane;
        const u32x2 w = *(const u32x2*)(H + off); const f32x4 h = (f32x4){bf_lo(w.x), bf_hi(w.x), bf_lo(w.y), bf_hi(w.y)};
        *(f32x4*)(out + off) = h + part4(pp) * scale; }
}
constexpr int VT_PITCH = 36;
constexpr int VT_BYTES = 64 * VT_PITCH * 2;
#if MSCAN
constexpr int ATT_WAVE_STRIDE = VT_BYTES;
#else
constexpr int ATT_WAVE_STRIDE = 16384;
#endif
constexpr int N_ATT_UNITS = NBP * 16 * (TP / 32) + NBS * 16 * (TS / 32);
__device__ __forceinline__ int crow(int r, int hi) { return (r & 3) + 8 * (r >> 2) + 4 * hi; }
__device__ __forceinline__ void attn_unit(const Params& p, int unit, LAS unsigned char* vtb, int lane, const bf16x8 (&mtri)[2]) {
    const int r32 = lane & 31, hi = lane >> 5;
    int h, qb, P; size_t row0; const float *kn, *vn, *kc = nullptr, *vc = nullptr;
    if (unit < NBP * 16 * (TP / 32)) { const int b = unit >> 12; h = (unit >> 8) & 15; qb = unit & 255; P = 0; row0 = (size_t)b * TP; kn = p.out + O_KP + row0 * SBW; vn = p.out + O_VP + row0 * SBW; }
    else { const int u2 = unit - NBP * 16 * (TP / 32); const int s = u2 >> 5; h = (u2 >> 1) & 15; qb = u2 & 1; P = PAST; row0 = (size_t)MPROMPT + (size_t)s * TS;
        kn = p.out + O_KS + (size_t)s * TS * SBW; vn = p.out + O_VS + (size_t)s * TS * SBW; kc = p.in[2] + (size_t)s * PAST * SBW; vc = p.in[3] + (size_t)s * PAST * SBW; }
    const bf16* Qb = (const bf16*)(p.ws + WS_QB) + (row0 + (size_t)qb * 32 + r32) * SBW + h * 64 + hi * 8;
    bf16x8 qf[4];
#pragma unroll
    for (int d0 = 0; d0 < 4; ++d0) qf[d0] = *(const bf16x8*)(Qb + 16 * d0);
    f32x16 o0 = {}, o1 = {}; float carry = 0.f;
    LAS unsigned short* vt = (LAS unsigned short*)vtb;
    const int nq = P + qb * 32;
    for (int n0 = nq; n0 >= 0; n0 -= 32) {
        const float* kb = (n0 >= P ? kn + (size_t)(n0 - P) * SBW : kc + (size_t)n0 * SBW) + h * 64;
        const float* vb = (n0 >= P ? vn + (size_t)(n0 - P) * SBW : vc + (size_t)n0 * SBW) + h * 64;
        f32x4 vr[8];
#pragma unroll
        for (int i = 0; i < 8; ++i) vr[i] = *(const f32x4*)(vb + (size_t)((lane >> 4) + 4 * i) * SBW + 4 * (lane & 15));
        f32x16 s = {};
#pragma unroll
        for (int d0 = 0; d0 < 4; ++d0) { const float* kp = kb + (size_t)r32 * SBW + 16 * d0 + 8 * hi; const f32x4 a = *(const f32x4*)kp, b = *(const f32x4*)(kp + 4);
            const v4u w = (v4u){cvtpk(a[0], a[1]), cvtpk(a[2], a[3]), cvtpk(b[0], b[1]), cvtpk(b[2], b[3])};
            s = __builtin_amdgcn_mfma_f32_32x32x16_bf16(__builtin_bit_cast(bf16x8, w), qf[d0], s, 0, 0, 0); }
#pragma unroll
        for (int i = 0; i < 8; ++i) { const int key = (lane >> 4) + 4 * i, d = 4 * (lane & 15); const unsigned w0 = cvtpk(vr[i][0], vr[i][1]), w1 = cvtpk(vr[i][2], vr[i][3]);
            vt[(d + 0) * VT_PITCH + key] = (unsigned short)(w0 & 0xffffu); vt[(d + 1) * VT_PITCH + key] = (unsigned short)(w0 >> 16);
            vt[(d + 2) * VT_PITCH + key] = (unsigned short)(w1 & 0xffffu); vt[(d + 3) * VT_PITCH + key] = (unsigned short)(w1 >> 16); }
        asm volatile("" ::: "memory");
        const bool diag = (n0 == nq);
        float lk[16], lb[16]; float lsum = 0.f;
#pragma unroll
        for (int r = 0; r < 16; ++r) { const float z = s[r]; const float sp = fmaxf(z, 0.f) + __logf(1.0f + __expf(-fabsf(z)));
            const bool valid = !diag || (crow(r, hi) < r32);
            lk[r] = valid ? -sp : 0.f; lb[r] = valid ? (z - sp) : -INFINITY; lsum += lk[r]; }
        f32x16 tl = {};
#pragma unroll
        for (int kk = 0; kk < 2; ++kk) { v4u wh, wl;
#pragma unroll
            for (int e = 0; e < 4; ++e) { const float x0 = lk[8 * kk + 2 * e], x1 = lk[8 * kk + 2 * e + 1]; const unsigned w = cvtpk(x0, x1); wh[e] = w; wl[e] = cvtpk(x0 - bf_lo(w), x1 - bf_hi(w)); }
            tl = __builtin_amdgcn_mfma_f32_32x32x16_bf16(mtri[kk], __builtin_bit_cast(bf16x8, wh), tl, 0, 0, 0);
            tl = __builtin_amdgcn_mfma_f32_32x32x16_bf16(mtri[kk], __builtin_bit_cast(bf16x8, wl), tl, 0, 0, 0); }
        v4u wk[2];
#pragma unroll
        for (int kk = 0; kk < 2; ++kk)
#pragma unroll
            for (int e = 0; e < 4; ++e) { const int r = 8 * kk + 2 * e; wk[kk][e] = cvtpk(__expf(lb[r] + carry + tl[r]), __expf(lb[r + 1] + carry + tl[r + 1])); }
#pragma unroll
        for (int kk = 0; kk < 2; ++kk) {
            const LAS unsigned short* a0p = vt + r32 * VT_PITCH + 16 * kk + 4 * hi; const LAS unsigned short* a1p = a0p + 32 * VT_PITCH;
            const u32x2 x0 = *(const LAS u32x2*)a0p, x1 = *(const LAS u32x2*)(a0p + 8), y0 = *(const LAS u32x2*)a1p, y1 = *(const LAS u32x2*)(a1p + 8);
            o0 = __builtin_amdgcn_mfma_f32_32x32x16_bf16(__builtin_bit_cast(bf16x8, (v4u){x0.x, x0.y, x1.x, x1.y}), __builtin_bit_cast(bf16x8, wk[kk]), o0, 0, 0, 0);
            o1 = __builtin_amdgcn_mfma_f32_32x32x16_bf16(__builtin_bit_cast(bf16x8, (v4u){y0.x, y0.y, y1.x, y1.y}), __builtin_bit_cast(bf16x8, wk[kk]), o1, 0, 0, 0); }
        asm volatile("" ::: "memory");
        lsum = xsum32(lsum); carry += lsum;
        if (__all(carry < -104.0f)) break;
    }
    bf16* O = (bf16*)(p.ws + WS_AO) + (row0 + (size_t)qb * 32 + r32) * SBW + h * 64 + 4 * hi;
#pragma unroll
    for (int g = 0; g < 4; ++g) { u32x2 a, b; a.x = cvtpk(o0[4 * g], o0[4 * g + 1]); a.y = cvtpk(o0[4 * g + 2], o0[4 * g + 3]); b.x = cvtpk(o1[4 * g], o1[4 * g + 1]); b.y = cvtpk(o1[4 * g + 2], o1[4 * g + 3]);
        *(u32x2*)(O + 8 * g) = a; *(u32x2*)(O + 32 + 8 * g) = b; }
}
constexpr int ATT_N1 = ATT_SPLIT1, ATT_N2 = ATT_SPLIT2;
__device__ __forceinline__ void attn_phase(const Params& p, LAS unsigned char* vt, unsigned* queue, int ubase, int ucount, int lane) {
    bf16x8 mtri[2]; const int r32 = lane & 31, hi = lane >> 5;
#pragma unroll
    for (int kk = 0; kk < 2; ++kk)
#pragma unroll
        for (int e = 0; e < 8; ++e) mtri[kk][e] = (crow(8 * kk + e, hi) > r32) ? (short)0x3F80 : (short)0;
    for (;;) {
        unsigned u = 0; if (lane == 0) u = __hip_atomic_fetch_add(queue, 1u, __ATOMIC_RELAXED, __HIP_MEMORY_SCOPE_AGENT);
        u = (unsigned)__builtin_amdgcn_readfirstlane((int)u);
        if (u >= (unsigned)ucount) break;
        attn_unit(p, ubase + (int)u, vt, lane, mtri);
    }
}
__device__ __forceinline__ void shift_phase(const Params& p, int gw, int NGW, int lane) {
    const bf16* PRW = (const bf16*)(p.ws + WS_PRW); const float* mu = p.in[15]; bf16* ACAT = (bf16*)(p.ws + WS_ACAT);
    for (int m = gw; m < M; m += NGW) {
        const bool prompt = m < MPROMPT; const int t = prompt ? (m & (TP - 1)) : ((m - MPROMPT) & (TS - 1)); const bool first = (t == 0);
        if (lane < 56) { const int col = 3072 + lane * 8;
            const v4u pw = *(const v4u*)(PRW + (size_t)m * RWCP + col); float pv[8], qv[8];
            pv[0] = bf_lo(pw.x); pv[1] = bf_hi(pw.x); pv[2] = bf_lo(pw.y); pv[3] = bf_hi(pw.y); pv[4] = bf_lo(pw.z); pv[5] = bf_hi(pw.z); pv[6] = bf_lo(pw.w); pv[7] = bf_hi(pw.w);
            if (!first) { const v4u qw = *(const v4u*)(PRW + (size_t)(m - 1) * RWCP + col);
                qv[0] = bf_lo(qw.x); qv[1] = bf_hi(qw.x); qv[2] = bf_lo(qw.y); qv[3] = bf_hi(qw.y); qv[4] = bf_lo(qw.z); qv[5] = bf_hi(qw.z); qv[6] = bf_lo(qw.w); qv[7] = bf_hi(qw.w); }
            else if (prompt) {
#pragma unroll
                for (int e = 0; e < 8; ++e) qv[e] = 0.f; }
            else { const float* sh0 = p.in[5] + (size_t)((m - MPROMPT) >> 6) * RWC; const f32x4 a = *(const f32x4*)(sh0 + col), b = *(const f32x4*)(sh0 + col + 4);
                qv[0] = a[0]; qv[1] = a[1]; qv[2] = a[2]; qv[3] = a[3]; qv[4] = b[0]; qv[5] = b[1]; qv[6] = b[2]; qv[7] = b[3]; }
            const f32x4 m0 = *(const f32x4*)(mu + col), m1 = *(const f32x4*)(mu + col + 4); float x[8];
#pragma unroll
            for (int e2 = 0; e2 < 8; ++e2) x[e2] = pv[e2] + (qv[e2] - pv[e2]) * (e2 < 4 ? m0[e2] : m1[e2 - 4]);
            bf16* dst;
            if (col < 3168) { dst = ACAT + (size_t)m * KLORA + (col - 3072);
#pragma unroll
                for (int e2 = 0; e2 < 8; ++e2) x[e2] = tanhf(x[e2]); }
            else if (col < 3264) dst = ACAT + (size_t)m * KLORA + 128 + (col - 3168);
            else { dst = ACAT + (size_t)m * KLORA + 256 + (col - 3264);
#pragma unroll
                for (int e2 = 0; e2 < 8; ++e2) x[e2] = pg8::sigm(x[e2]); }
            *(v4u*)dst = (v4u){cvtpk(x[0], x[1]), cvtpk(x[2], x[3]), cvtpk(x[4], x[5]), cvtpk(x[6], x[7])};
        } else *(v4u*)(ACAT + (size_t)m * KLORA + (lane < 60 ? 96 + 8 * (lane - 56) : 224 + 8 * (lane - 60))) = (v4u){0u, 0u, 0u, 0u};
    }
}
typedef float f2 __attribute__((ext_vector_type(2)));
constexpr int SC_BLK = 8, SC_ARR = 1024, SC_W = 6 * SC_ARR, SC_BUF = SC_W + 2 * SC_ARR, SC_WAVE = 2 * SC_BUF;
static_assert(NWAVES * SC_WAVE <= RING_BYTES && CH % SC_BLK == 0 && TS % SC_BLK == 0, "scan staging");
__device__ __forceinline__ void cvt8(const v4u q, float (&f)[8]) { f[0] = bf_lo(q.x); f[1] = bf_hi(q.x); f[2] = bf_lo(q.y); f[3] = bf_hi(q.y); f[4] = bf_lo(q.z); f[5] = bf_hi(q.z); f[6] = bf_lo(q.w); f[7] = bf_hi(q.w); }
__device__ __forceinline__ void cvt8p(const v4u q, f2 (&f)[4]) { f[0] = (f2){bf_lo(q.x), bf_hi(q.x)}; f[1] = (f2){bf_lo(q.y), bf_hi(q.y)}; f[2] = (f2){bf_lo(q.z), bf_hi(q.z)}; f[3] = (f2){bf_lo(q.w), bf_hi(q.w)}; }
template <bool WITH_Y> __device__ __forceinline__ void stage_issue(const unsigned char* ws, size_t mblk, int h, int lane, LAS unsigned char* buf) {
    const size_t o = (mblk + (lane >> 3)) * RWW + h * 64 + (lane & 7) * 8;
    __builtin_amdgcn_global_load_lds((const unsigned*)((const bf16*)(ws + WS_KKN) + o), (LAS unsigned*)(buf + 0 * SC_ARR), 16, 0, 0);
    __builtin_amdgcn_global_load_lds((const unsigned*)((const bf16*)(ws + WS_BV) + o), (LAS unsigned*)(buf + 1 * SC_ARR), 16, 0, 0);
    __builtin_amdgcn_global_load_lds((const unsigned*)((const bf16*)(ws + WS_KP) + o), (LAS unsigned*)(buf + 2 * SC_ARR), 16, 0, 0);
    __builtin_amdgcn_global_load_lds((const unsigned*)((const bf16*)(ws + WS_XV) + o), (LAS unsigned*)(buf + 3 * SC_ARR), 16, 0, 0);
    if (WITH_Y) { __builtin_amdgcn_global_load_lds((const unsigned*)((const bf16*)(ws + WS_XR) + o), (LAS unsigned*)(buf + 4 * SC_ARR), 16, 0, 0);
                  __builtin_amdgcn_global_load_lds((const unsigned*)((const bf16*)(ws + WS_G) + o), (LAS unsigned*)(buf + 5 * SC_ARR), 16, 0, 0); }
    const float* wp = (const float*)(ws + WS_WD) + (mblk + (lane >> 4)) * RWW + h * 64 + (lane & 15) * 4;
    __builtin_amdgcn_global_load_lds((const unsigned*)wp, (LAS unsigned*)(buf + SC_W), 16, 0, 0);
    __builtin_amdgcn_global_load_lds((const unsigned*)(wp + 4 * RWW), (LAS unsigned*)(buf + SC_W + SC_ARR), 16, 0, 0);
}
#define STAGE_LANDED() asm volatile("s_waitcnt vmcnt(0)" ::: "memory")
#define SCAN_DOT(X, V2, OUT) do { _Pragma("unroll") for (int a = 0; a < 8; ++a) { f2 s_ = X[a][0] * V2[0]; _Pragma("unroll") for (int c = 1; c < 4; ++c) s_ = X[a][c] * V2[c] + s_; OUT[a] = red8(s_.x + s_.y); } } while (0)

__device__ __forceinline__ void scan_pass_a(const Params& p, int unit, LAS unsigned char* wbuf, int lane) {
    const int bh = unit / NCH, c = unit % NCH, b = bh >> 4, h = bh & 15, li = lane >> 3, lj = lane & 7;
    const size_t m0 = (size_t)b * TP + (size_t)c * CH;
    f2 U[8][4], Pm[8][4];
#pragma unroll
    for (int a = 0; a < 8; ++a)
#pragma unroll
        for (int cc = 0; cc < 4; ++cc) { U[a][cc] = (f2){0.f, 0.f}; Pm[a][cc] = (f2){(8 * li + a == 8 * lj + 2 * cc) ? 1.f : 0.f, (8 * li + a == 8 * lj + 2 * cc + 1) ? 1.f : 0.f}; }
    stage_issue<false>(p.ws, m0, h, lane, wbuf);
    STAGE_LANDED();
#pragma unroll 1
    for (int k = 0; k < CH / SC_BLK; ++k) {
        LAS unsigned char* cur = wbuf + (k & 1) * SC_BUF;
        if (k + 1 < CH / SC_BLK) stage_issue<false>(p.ws, m0 + (size_t)(k + 1) * SC_BLK, h, lane, wbuf + ((k + 1) & 1) * SC_BUF);
#pragma unroll 1
        for (int t = 0; t < SC_BLK; ++t) {
            f2 kn[4], bb[4], kp[4], w[4]; float v[8];
            cvt8p(*(const LAS v4u*)(cur + 0 * SC_ARR + t * 128 + lj * 16), kn); cvt8p(*(const LAS v4u*)(cur + 1 * SC_ARR + t * 128 + lj * 16), bb); cvt8p(*(const LAS v4u*)(cur + 2 * SC_ARR + t * 128 + lj * 16), kp);
            cvt8(*(const LAS v4u*)(cur + 3 * SC_ARR + t * 128 + li * 16), v);
            { const f32x4 w0 = *(const LAS f32x4*)(cur + SC_W + t * 256 + lj * 32), w1 = *(const LAS f32x4*)(cur + SC_W + t * 256 + lj * 32 + 16);
              w[0] = (f2){w0[0], w0[1]}; w[1] = (f2){w0[2], w0[3]}; w[2] = (f2){w1[0], w1[1]}; w[3] = (f2){w1[2], w1[3]}; }
            float du[8], dp[8];
            SCAN_DOT(U, kn, du); SCAN_DOT(Pm, kn, dp);
#pragma unroll
            for (int a = 0; a < 8; ++a)
#pragma unroll
                for (int cc = 0; cc < 4; ++cc) { U[a][cc] = U[a][cc] * w[cc] + (kp[cc] * v[a] - bb[cc] * du[a]); Pm[a][cc] = Pm[a][cc] * w[cc] - bb[cc] * dp[a]; }
        }
        STAGE_LANDED();
    }
    float* Uo = (float*)(p.ws + WS_UC) + (size_t)unit * 4096; float* Po = (float*)(p.ws + WS_PC) + (size_t)unit * 4096;
#pragma unroll
    for (int a = 0; a < 8; ++a) { float* up = Uo + (8 * li + a) * 64 + 8 * lj; *(f32x4*)up = (f32x4){U[a][0].x, U[a][0].y, U[a][1].x, U[a][1].y}; *(f32x4*)(up + 4) = (f32x4){U[a][2].x, U[a][2].y, U[a][3].x, U[a][3].y}; }
#pragma unroll
    for (int cc = 0; cc < 8; ++cc)
#pragma unroll
        for (int ah = 0; ah < 2; ++ah) { const int jb = li >> 1, kq = (2 * li + ah) & 3, jpb = lj >> 1, jpl = 8 * (lj & 1) + cc;
            *(f32x4*)(Po + (((jpb * 4 + jb) * 64 + kq * 16 + jpl) * 4)) = (f32x4){Pm[4 * ah][cc >> 1][cc & 1], Pm[4 * ah + 1][cc >> 1][cc & 1], Pm[4 * ah + 2][cc >> 1][cc & 1], Pm[4 * ah + 3][cc >> 1][cc & 1]}; }
}
__device__ __forceinline__ void scan_pass_c(const Params& p, size_t m0, int h, int nsteps, const float* S0, float* Sfin, LAS unsigned char* wbuf, int lane) {
    const int li = lane >> 3, lj = lane & 7; const int cj = h * 64 + 8 * lj, ci = h * 64 + 8 * li;
    f2 S[8][4];
#pragma unroll
    for (int a = 0; a < 8; ++a) { const float* sp = S0 + (8 * li + a) * 64 + 8 * lj; const f32x4 x0 = *(const f32x4*)sp, x1 = *(const f32x4*)(sp + 4);
        S[a][0] = (f2){x0[0], x0[1]}; S[a][1] = (f2){x0[2], x0[3]}; S[a][2] = (f2){x1[0], x1[1]}; S[a][3] = (f2){x1[2], x1[3]}; }
    float lnw[8], lnb[8]; f2 rk[4];
    { const f32x4 a0 = *(const f32x4*)(p.in[24] + ci), a1 = *(const f32x4*)(p.in[24] + ci + 4), b0 = *(const f32x4*)(p.in[25] + ci), b1 = *(const f32x4*)(p.in[25] + ci + 4), c0 = *(const f32x4*)(p.in[23] + cj), c1 = *(const f32x4*)(p.in[23] + cj + 4);
#pragma unroll
        for (int e = 0; e < 4; ++e) { lnw[e] = a0[e]; lnw[4 + e] = a1[e]; lnb[e] = b0[e]; lnb[4 + e] = b1[e]; }
        rk[0] = (f2){c0[0], c0[1]}; rk[1] = (f2){c0[2], c0[3]}; rk[2] = (f2){c1[0], c1[1]}; rk[3] = (f2){c1[2], c1[3]}; }
    bf16* Y = (bf16*)(p.ws + WS_YRW);
    const int nblk = nsteps / SC_BLK;
    stage_issue<true>(p.ws, m0, h, lane, wbuf);
    STAGE_LANDED();
#pragma unroll 1
    for (int k = 0; k < nblk; ++k) {
        LAS unsigned char* cur = wbuf + (k & 1) * SC_BUF;
        if (k + 1 < nblk) stage_issue<true>(p.ws, m0 + (size_t)(k + 1) * SC_BLK, h, lane, wbuf + ((k + 1) & 1) * SC_BUF);
#pragma unroll 1
        for (int t = 0; t < SC_BLK; ++t) {
            f2 kn[4], bb[4], kp[4], w[4], r[4]; float v[8], g[8];
            cvt8p(*(const LAS v4u*)(cur + 0 * SC_ARR + t * 128 + lj * 16), kn); cvt8p(*(const LAS v4u*)(cur + 1 * SC_ARR + t * 128 + lj * 16), bb); cvt8p(*(const LAS v4u*)(cur + 2 * SC_ARR + t * 128 + lj * 16), kp);
            cvt8(*(const LAS v4u*)(cur + 3 * SC_ARR + t * 128 + li * 16), v); cvt8p(*(const LAS v4u*)(cur + 4 * SC_ARR + t * 128 + lj * 16), r); cvt8(*(const LAS v4u*)(cur + 5 * SC_ARR + t * 128 + li * 16), g);
            { const f32x4 w0 = *(const LAS f32x4*)(cur + SC_W + t * 256 + lj * 32), w1 = *(const LAS f32x4*)(cur + SC_W + t * 256 + lj * 32 + 16);
              w[0] = (f2){w0[0], w0[1]}; w[1] = (f2){w0[2], w0[3]}; w[2] = (f2){w1[0], w1[1]}; w[3] = (f2){w1[2], w1[3]}; }
            float ds[8], y[8];
            SCAN_DOT(S, kn, ds);
#pragma unroll
            for (int a = 0; a < 8; ++a)
#pragma unroll
                for (int cc = 0; cc < 4; ++cc) S[a][cc] = S[a][cc] * w[cc] + (kp[cc] * v[a] - bb[cc] * ds[a]);
            SCAN_DOT(S, r, y);
            f2 rk2 = r[0] * kp[0] * rk[0];
#pragma unroll
            for (int cc = 1; cc < 4; ++cc) rk2 = r[cc] * kp[cc] * rk[cc] + rk2;
            const float rkk = red8(rk2.x + rk2.y);
            float s1 = 0.f, s2 = 0.f;
#pragma unroll
            for (int a = 0; a < 8; ++a) { s1 += y[a]; s2 += y[a] * y[a]; }
            s1 = red_hi8(s1); s2 = red_hi8(s2);
            const float mean = s1 * (1.0f / 64.0f); const float var = fmaxf(s2 * (1.0f / 64.0f) - mean * mean, 0.f);
            const float rstd = __builtin_amdgcn_rsqf(var + 64e-5f);
            float o[8];
#pragma unroll
            for (int a = 0; a < 8; ++a) o[a] = (((y[a] - mean) * rstd) * lnw[a] + lnb[a] + rkk * v[a]) * g[a];
            if (lj == 0) *(v4u*)(Y + (m0 + (size_t)k * SC_BLK + t) * RWW + ci) = (v4u){cvtpk(o[0], o[1]), cvtpk(o[2], o[3]), cvtpk(o[4], o[5]), cvtpk(o[6], o[7])};
        }
        STAGE_LANDED();
    }
    if (Sfin) {
#pragma unroll
        for (int a = 0; a < 8; ++a) { float* sp = Sfin + (8 * li + a) * 64 + 8 * lj; *(f32x4*)sp = (f32x4){S[a][0].x, S[a][0].y, S[a][1].x, S[a][1].y}; *(f32x4*)(sp + 4) = (f32x4){S[a][2].x, S[a][2].y, S[a][3].x, S[a][3].y}; }
    }
}
__device__ __forceinline__ void scan_pass_b(const Params& p, int unit, int lane) {
    const int bh = unit >> 2, ib = unit & 3, i = lane & 15, q4 = lane >> 4;
    const float* Pc = (const float*)(p.ws + WS_PC) + (size_t)bh * NCH * 4096; const float* Uc = (const float*)(p.ws + WS_UC) + (size_t)bh * NCH * 4096; float* Sc = (float*)(p.ws + WS_SC) + (size_t)bh * NCH * 4096;
    const int roff = (16 * ib + i) * 64 + 4 * q4;
    f32x4 S[4];
#pragma unroll
    for (int jb = 0; jb < 4; ++jb) S[jb] = (f32x4){0.f, 0.f, 0.f, 0.f};
    f32x4 pa[4][4], un[4];
#pragma unroll
    for (int x = 0; x < 4; ++x) { un[x] = *(const f32x4*)(Uc + roff + 16 * x);
#pragma unroll
        for (int jb = 0; jb < 4; ++jb) pa[x][jb] = *(const f32x4*)(Pc + ((x * 4 + jb) * 64 + lane) * 4); }
#pragma unroll 1
    for (int c = 0; c < NCH; ++c) {
#pragma unroll
        for (int jb = 0; jb < 4; ++jb) *(f32x4*)(Sc + (size_t)c * 4096 + roff + 16 * jb) = S[jb];
        f32x4 pc[4][4], acc[4];
#pragma unroll
        for (int x = 0; x < 4; ++x) { acc[x] = un[x];
#pragma unroll
            for (int jb = 0; jb < 4; ++jb) pc[x][jb] = pa[x][jb]; }
        if (c + 1 < NCH) {
#pragma unroll
            for (int x = 0; x < 4; ++x) { un[x] = *(const f32x4*)(Uc + (size_t)(c + 1) * 4096 + roff + 16 * x);
#pragma unroll
                for (int jb = 0; jb < 4; ++jb) pa[x][jb] = *(const f32x4*)(Pc + (size_t)(c + 1) * 4096 + ((x * 4 + jb) * 64 + lane) * 4); } }
#pragma unroll
        for (int x = 0; x < 4; ++x)
#pragma unroll
            for (int jb = 0; jb < 4; ++jb)
#pragma unroll
                for (int e = 0; e < 4; ++e) acc[x] = __builtin_amdgcn_mfma_f32_16x16x4f32(pc[x][jb][e], S[jb][e], acc[x], 0, 0, 0);
#pragma unroll
        for (int x = 0; x < 4; ++x) S[x] = acc[x];
    }
    float* Sf = p.out + O_WKVP + (size_t)bh * 4096;
#pragma unroll
    for (int jb = 0; jb < 4; ++jb) *(f32x4*)(Sf + roff + 16 * jb) = S[jb];
}
namespace ms {
constexpr int SB = 16;
constexpr int RAW_W = 0, RAW_KN = 2048, RAW_BV = 4096, RAW_KP = 6144, RAW_XR = 8192, RAW_XV = 10240, RAW_BYTES = 14336;
constexpr int XA_PB = 144, XT_PB = 80;
constexpr int D_XA = RAW_BYTES;
constexpr int D_XB = D_XA + 32 * XA_PB;
constexpr int SV_PB = 64;
constexpr int D_SVT = D_XB;
constexpr int D_RH = D_XA;
constexpr int D_XBT = D_XA + 9216;
constexpr int D_MBF = D_XBT + 64 * XT_PB;
constexpr int D_ARHS = D_MBF + 1024;
constexpr int D_RA = D_ARHS + 16 * XT_PB;
constexpr int D_GAM = D_RA + 16 * XT_PB;
constexpr int D_RKK = D_GAM + 256;
constexpr int WAVE_BYTES = 32768;
static_assert(D_XB + 32 * XA_PB == D_XBT && D_RH + 4096 <= D_XB && D_SVT + 64 * SV_PB <= D_XBT && D_RKK + 64 <= WAVE_BYTES && 4 * WAVE_BYTES <= RING_BYTES, "mscan LDS map");
typedef float f4 __attribute__((ext_vector_type(4)));
__device__ __forceinline__ f4 mfma16(const bf16x8 a, const bf16x8 b, const f4 c) { return __builtin_amdgcn_mfma_f32_16x16x32_bf16(a, b, c, 0, 0, 0); }
__device__ __forceinline__ float bfu(unsigned short u) { return __uint_as_float((unsigned)u << 16); }
__device__ __forceinline__ bf16x8 pack_f8(const f4 a, const f4 b) { const v4u w = (v4u){cvtpk(a[0], a[1]), cvtpk(a[2], a[3]), cvtpk(b[0], b[1]), cvtpk(b[2], b[3])}; return __builtin_bit_cast(bf16x8, w); }
__device__ __forceinline__ void raw_issue(const unsigned char* ws, size_t mblk, int h, int lane, LAS unsigned char* raw) {
    ws = *(const unsigned char* const __attribute__((address_space(4)))*)((const __attribute__((address_space(4))) char*)__builtin_amdgcn_kernarg_segment_ptr() + __builtin_offsetof(Params, ws));
    const size_t ub = (mblk * RWW + (size_t)h * 64);
    unsigned lb = (unsigned)(((lane >> 3) * RWW + (lane & 7) * 8) * 2);
    unsigned lp = (unsigned)(((lane >> 3) * RWCP + (lane & 7) * 8) * 2);
    asm volatile("" : "+v"(lb), "+v"(lp));
    const unsigned char* b0 = ws + WS_KKN + ub * 2; const unsigned char* b1 = ws + WS_BV + ub * 2; const unsigned char* b2 = ws + WS_KP + ub * 2; const unsigned char* b3 = ws + WS_PRW + (mblk * RWCP + (size_t)h * 64) * 2; const unsigned char* b4 = b3 + 2048 * 2; const unsigned char* b5 = ws + WS_WD + ub * 2;
#pragma unroll
    for (int i = 0; i < 2; ++i) { const size_t oo = (size_t)i * 8 * RWW * 2;
        __builtin_amdgcn_global_load_lds((const unsigned*)(b5 + lb + oo), (LAS unsigned*)(raw + RAW_W + i * 1024), 16, 0, 0);
        __builtin_amdgcn_global_load_lds((const unsigned*)(b0 + lb + oo), (LAS unsigned*)(raw + RAW_KN + i * 1024), 16, 0, 0);
        __builtin_amdgcn_global_load_lds((const unsigned*)(b1 + lb + oo), (LAS unsigned*)(raw + RAW_BV + i * 1024), 16, 0, 0); asm volatile("" ::: "memory");
        __builtin_amdgcn_global_load_lds((const unsigned*)(b2 + lb + oo), (LAS unsigned*)(raw + RAW_KP + i * 1024), 16, 0, 0);
        __builtin_amdgcn_global_load_lds((const unsigned*)(b3 + lp + (size_t)i * 8 * RWCP * 2), (LAS unsigned*)(raw + RAW_XR + i * 1024), 16, 0, 0);
        __builtin_amdgcn_global_load_lds((const unsigned*)(b4 + lp + (size_t)i * 8 * RWCP * 2), (LAS unsigned*)(raw + RAW_XV + i * 1024), 16, 0, 0); asm volatile("" ::: "memory"); }
}
template <bool WITH_Y> __device__ __forceinline__ void stage_a(LAS unsigned char* wb, int lane, float rkj, unsigned (&vt)[8], float mur, float muv, float& pr, float& pv) {
    const LAS unsigned short* kn = (const LAS unsigned short*)(wb + RAW_KN) + lane; const LAS unsigned short* bv = (const LAS unsigned short*)(wb + RAW_BV) + lane;
    const LAS unsigned short* kp = (const LAS unsigned short*)(wb + RAW_KP) + lane; const LAS unsigned short* xr = (const LAS unsigned short*)(wb + RAW_XR) + lane;
    const LAS unsigned short* xv = (const LAS unsigned short*)(wb + RAW_XV) + lane; const LAS unsigned short* wd = (const LAS unsigned short*)(wb + RAW_W) + lane;
    LAS unsigned short* XA = (LAS unsigned short*)(wb + D_XA) + lane; LAS unsigned short* XB = (LAS unsigned short*)(wb + D_XB) + lane;
    float gp = 1.f; unsigned bt[8], kt[8]; float bprev = 0.f, kprev = 0.f; float pd[16];
#pragma unroll
    for (int hf = 0; hf < 2; ++hf) {
        unsigned short rw[8], rkn[8], rbv[8], rkp[8], rxr[8];
#pragma unroll
        for (int tt = 0; tt < 8; ++tt) { const int t = 8 * hf + tt; rw[tt] = wd[t * 64]; rkn[tt] = kn[t * 64]; rbv[tt] = bv[t * 64]; rkp[tt] = kp[t * 64]; rxr[tt] = xr[t * 64]; }
        asm volatile("" ::: "memory");
#pragma unroll
        for (int tt = 0; tt < 8; ++tt) { const int t = 8 * hf + tt;
            const float w = __expf(-bfu(rw[tt])), a = bfu(rkn[tt]), b = bfu(rbv[tt]), k = bfu(rkp[tt]), rp = bfu(rxr[tt]); const float r = rp + (pr - rp) * mur; pr = rp;
            const float gc = gp * w, gi = __builtin_amdgcn_rcpf(gc);
            const float at = -a * gp, rt = r * gc, b2 = b * gi, k2 = k * gi;
            const unsigned war = cvtpk(at, rt), wbk = cvtpk(b2, k2);
            XA[t * (XA_PB / 2)] = (unsigned short)(war & 0xffffu); XA[(16 + t) * (XA_PB / 2)] = (unsigned short)(war >> 16);
            XB[t * (XA_PB / 2)] = (unsigned short)(wbk & 0xffffu); XB[(16 + t) * (XA_PB / 2)] = (unsigned short)(wbk >> 16);
            if (t & 1) { bt[t >> 1] = cvtpk(bprev, b2); kt[t >> 1] = cvtpk(kprev, k2); } else { bprev = b2; kprev = k2; }
            if (WITH_Y) pd[t] = r * k * rkj;
            gp = gc; }
        asm volatile("" ::: "memory");
    }
    if (WITH_Y) {
#pragma unroll
        for (int t = 0; t < 16; ++t) pd[t] = wave_sum(pd[t]);
        if (lane == 0) { LAS f4* o = (LAS f4*)(wb + D_RKK); o[0] = (f4){pd[0], pd[1], pd[2], pd[3]}; o[1] = (f4){pd[4], pd[5], pd[6], pd[7]}; o[2] = (f4){pd[8], pd[9], pd[10], pd[11]}; o[3] = (f4){pd[12], pd[13], pd[14], pd[15]}; } }
    *(LAS float*)(wb + D_GAM + lane * 4) = gp;
    { LAS v4u* row = (LAS v4u*)(wb + D_XBT + lane * XT_PB); row[0] = (v4u){bt[0], bt[1], bt[2], bt[3]}; row[1] = (v4u){bt[4], bt[5], bt[6], bt[7]}; row[2] = (v4u){kt[0], kt[1], kt[2], kt[3]}; row[3] = (v4u){kt[4], kt[5], kt[6], kt[7]}; }
#pragma unroll
    for (int t = 0; t < 8; ++t) { const float p0 = bfu(xv[(2 * t) * 64]), p1 = bfu(xv[(2 * t + 1) * 64]); vt[t] = cvtpk(p0 + (pv - p0) * muv, p1 + (p0 - p1) * muv); pv = p1; }
    asm volatile("" ::: "memory");
}
__device__ __forceinline__ void gram(LAS unsigned char* wb, int lane, f32x16& G) {
    const int tp = lane & 31, hi = lane >> 5; G = (f32x16){};
#pragma unroll
    for (int ks = 0; ks < 4; ++ks) { const bf16x8 a = *(const LAS bf16x8*)(wb + D_XB + tp * XA_PB + (16 * ks + 8 * hi) * 2), b = *(const LAS bf16x8*)(wb + D_XA + tp * XA_PB + (16 * ks + 8 * hi) * 2);
        G = __builtin_amdgcn_mfma_f32_32x32x16_bf16(a, b, G, 0, 0, 0); }
#pragma unroll
    for (int rg = 0; rg < 4; ++rg) { const int sb = 8 * rg + 4 * hi;
        if (tp < 16) { const int t = tp;
            if (rg < 2) { f4 m;
#pragma unroll
                for (int e = 0; e < 4; ++e) m[e] = (sb + e < t) ? G[4 * rg + e] : 0.f;
                (void)m; *(LAS u32x2*)(wb + D_ARHS + t * XT_PB + sb * 2) = (u32x2){0u, 0u}; }
            else { float m[4];
#pragma unroll
                for (int e = 0; e < 4; ++e) m[e] = (sb - 16 + e < t) ? G[4 * rg + e] : 0.f;
                *(LAS u32x2*)(wb + D_ARHS + t * XT_PB + sb * 2) = (u32x2){cvtpk(m[0], m[1]), cvtpk(m[2], m[3])}; } }
        else { const int t = tp - 16; float m[4];
#pragma unroll
            for (int e = 0; e < 4; ++e) m[e] = (((sb + e) & 15) <= t) ? G[4 * rg + e] : 0.f;
            *(LAS u32x2*)(wb + D_RA + t * XT_PB + sb * 2) = (u32x2){cvtpk(m[0], m[1]), cvtpk(m[2], m[3])}; } }
}
template <int NTB> __device__ __forceinline__ void s0_products(LAS unsigned char* wb, int lane, const f4 (&S)[4][4], f4 (&D)[NTB][4]) {
    const int n = lane & 15, q = lane >> 4;
#pragma unroll
    for (int tb = 0; tb < NTB; ++tb)
#pragma unroll
        for (int ib = 0; ib < 4; ++ib) D[tb][ib] = (f4){0.f, 0.f, 0.f, 0.f};
#pragma unroll
    for (int kk = 0; kk < 2; ++kk) { bf16x8 A[NTB];
#pragma unroll
        for (int tb = 0; tb < NTB; ++tb) { const LAS unsigned char* ap = wb + D_XA + (16 * tb + n) * XA_PB + (32 * kk + 4 * q) * 2; const u32x2 lo = *(const LAS u32x2*)ap, h2 = *(const LAS u32x2*)(ap + 32);
            A[tb] = __builtin_bit_cast(bf16x8, (v4u){lo.x, lo.y, h2.x, h2.y}); }
#pragma unroll
        for (int ib = 0; ib < 4; ++ib) { const bf16x8 B = pack_f8(S[2 * kk][ib], S[2 * kk + 1][ib]);
#pragma unroll
            for (int tb = 0; tb < NTB; ++tb) D[tb][ib] = mfma16(A[tb], B, D[tb][ib]); } }
}
__device__ __forceinline__ void solve_rows(LAS unsigned char* wb, int lane, const f4 (&RHT)[4], float (&g)[8]) {
    const int n = lane & 15, q = lane >> 4;
#pragma unroll
    for (int ib = 0; ib < 4; ++ib) *(LAS f4*)(wb + D_RH + ((16 * ib + n) * 16 + 4 * q) * 4) = RHT[ib];
    float sa[16];
    { const LAS f4* r4 = (const LAS f4*)(wb + D_RH + lane * 64);
#pragma unroll
        for (int c = 0; c < 4; ++c) { const f4 x = r4[c]; sa[4 * c] = x[0]; sa[4 * c + 1] = x[1]; sa[4 * c + 2] = x[2]; sa[4 * c + 3] = x[3]; } }
#pragma unroll
    for (int s = 0; s < 15; ++s) { const int hi = (s >> 2) & 1, r = (s & 3) + 4 * (s >> 3);
#pragma unroll
        for (int t = s + 1; t < 16; ++t) sa[t] += sa[s] * __int_as_float(__builtin_amdgcn_readlane(__float_as_int(g[r]), t + 32 * hi));
        asm volatile("" : "+v"(g[0]), "+v"(g[1]), "+v"(g[2]), "+v"(g[3]), "+v"(g[4]), "+v"(g[5]), "+v"(g[6]), "+v"(g[7])); }
    LAS v4u* row = (LAS v4u*)(wb + D_SVT + lane * SV_PB);
    row[0] = (v4u){cvtpk(sa[0], sa[1]), cvtpk(sa[2], sa[3]), cvtpk(sa[4], sa[5]), cvtpk(sa[6], sa[7])}; row[1] = (v4u){cvtpk(sa[8], sa[9]), cvtpk(sa[10], sa[11]), cvtpk(sa[12], sa[13]), cvtpk(sa[14], sa[15])};
}
template <bool WITH_Y> __device__ __forceinline__ void update_state(LAS unsigned char* wb, int lane, f4 (&S)[4][4], f4 (&YT)[4]) {
    const int n = lane & 15, q = lane >> 4; bf16x8 xb[4], ra;
#pragma unroll
    for (int jb = 0; jb < 4; ++jb) xb[jb] = *(const LAS bf16x8*)(wb + D_XBT + (16 * jb + n) * XT_PB + 16 * q);
    if (WITH_Y) ra = *(const LAS bf16x8*)(wb + D_RA + n * XT_PB + 16 * q);
#pragma unroll
    for (int ib = 0; ib < 4; ++ib) { const bf16x8 sv = *(const LAS bf16x8*)(wb + D_SVT + (16 * ib + n) * SV_PB + 16 * q);
        if (WITH_Y) YT[ib] = mfma16(ra, sv, YT[ib]);
#pragma unroll
        for (int jb = 0; jb < 4; ++jb) S[jb][ib] = mfma16(xb[jb], sv, S[jb][ib]); }
#pragma unroll
    for (int jb = 0; jb < 4; ++jb) { const f4 gm = *(const LAS f4*)(wb + D_GAM + (16 * jb + 4 * q) * 4);
#pragma unroll
        for (int ib = 0; ib < 4; ++ib) S[jb][ib] *= gm; }
}
__device__ __forceinline__ void load_state(const float* S0, int lane, f4 (&S)[4][4]) { const int n = lane & 15, q = lane >> 4;
#pragma unroll
    for (int jb = 0; jb < 4; ++jb)
#pragma unroll
        for (int ib = 0; ib < 4; ++ib) S[jb][ib] = *(const f4*)(S0 + (16 * ib + n) * 64 + 16 * jb + 4 * q); }
__device__ __forceinline__ void store_state(float* Sf, int lane, const f4 (&S)[4][4]) { const int n = lane & 15, q = lane >> 4;
#pragma unroll
    for (int jb = 0; jb < 4; ++jb)
#pragma unroll
        for (int ib = 0; ib < 4; ++ib) *(f4*)(Sf + (16 * ib + n) * 64 + 16 * jb + 4 * q) = S[jb][ib]; }
__device__ __forceinline__ void prev_init(const Params& p, size_t m0, int h, int lane, bool start, const float* shift0, float& pr, float& pv) {
    if (start) { pr = shift0 ? shift0[h * 64 + lane] : 0.f; pv = shift0 ? shift0[2048 + h * 64 + lane] : 0.f; }
    else { const bf16* q = (const bf16*)(p.ws + WS_PRW) + (m0 - 1) * RWCP + h * 64 + lane; pr = bfu(q[0]); pv = bfu(q[2048]); }
}
#define MS_LANDED() asm volatile("s_waitcnt vmcnt(0)" ::: "memory")
#define MS_LDS_DONE() asm volatile("s_waitcnt lgkmcnt(0)" ::: "memory")

__device__ __forceinline__ void scan_c(const Params& p, size_t m0, int h, int nsub, const float* S0, float* Sfin, bool start, const float* shift0, LAS unsigned char* wb, int lane) {
    const int n = lane & 15, q = lane >> 4;
    f4 S[4][4]; load_state(S0, lane, S);
    float lnw[4], lnb[4];
#pragma unroll
    for (int ib = 0; ib < 4; ++ib) { lnw[ib] = p.in[24][h * 64 + 16 * ib + n]; lnb[ib] = p.in[25][h * 64 + 16 * ib + n]; }
    const float rkj = p.in[23][h * 64 + lane], mur = p.in[15][h * 64 + lane], muv = p.in[15][2048 + h * 64 + lane]; float pr, pv; prev_init(p, m0, h, lane, start, shift0, pr, pv); const int loff = 4 * q * RWW + n;
    const bf16* Gt = (const bf16*)(p.ws + WS_G); bf16* Y = (bf16*)(p.ws + WS_YRW);
    raw_issue(p.ws, m0, h, lane, wb);
    typedef unsigned short us2 __attribute__((ext_vector_type(2))); us2 gn[4][2];
#pragma unroll
    for (int e = 0; e < 4; ++e)
#pragma unroll
        for (int ib = 0; ib < 4; ++ib) { const bf16* gb = Gt + m0 * RWW + h * 64; gn[e][ib >> 1][ib & 1] = gb[loff + e * RWW + 16 * ib]; }
#pragma unroll 1
    for (int k = 0; k < nsub; ++k) {
        const size_t mb = m0 + (size_t)k * SB;
        asm volatile("s_waitcnt vmcnt(16)" ::: "memory");
        unsigned vt[8]; stage_a<true>(wb, lane, rkj, vt, mur, muv, pr, pv);
        MS_LDS_DONE();
        if (k + 1 < nsub) raw_issue(p.ws, mb + SB, h, lane, wb);
        float g[8]; { f32x16 G; gram(wb, lane, G);
#pragma unroll
            for (int r = 0; r < 8; ++r) g[r] = G[r]; } asm volatile("" ::: "memory");
        { LAS v4u* row = (LAS v4u*)(wb + D_SVT + lane * SV_PB); row[0] = (v4u){0u, 0u, 0u, 0u}; row[1] = (v4u){0u, 0u, 0u, 0u}; row[2] = (v4u){vt[0], vt[1], vt[2], vt[3]}; row[3] = (v4u){vt[4], vt[5], vt[6], vt[7]}; }
        asm volatile("" ::: "memory");
        f4 D[2][4]; s0_products<2>(wb, lane, S, D); asm volatile("" ::: "memory");
        { const bf16x8 ar = *(const LAS bf16x8*)(wb + D_ARHS + n * XT_PB + 16 * q);
#pragma unroll
            for (int ib = 0; ib < 4; ++ib) { const bf16x8 sv = *(const LAS bf16x8*)(wb + D_SVT + (16 * ib + n) * SV_PB + 16 * q); D[0][ib] = mfma16(ar, sv, D[0][ib]); } }
        asm volatile("" ::: "memory"); solve_rows(wb, lane, D[0], g); asm volatile("" ::: "memory");
        update_state<true>(wb, lane, S, D[1]); asm volatile("" ::: "memory");
        const f4 rk4 = *(const LAS f4*)(wb + D_RKK + 16 * q); bf16* yb = Y + mb * RWW + h * 64;
        u32x2 vv[4];
#pragma unroll
        for (int ib = 0; ib < 4; ++ib) vv[ib] = *(const LAS u32x2*)(wb + D_SVT + (16 * ib + n) * SV_PB + (16 + 4 * q) * 2);
#pragma unroll
        for (int e = 0; e < 4; ++e) { float s1 = 0.f, s2 = 0.f;
#pragma unroll
            for (int ib = 0; ib < 4; ++ib) { const float y = D[1][ib][e]; s1 += y; s2 += y * y; }
            s1 = row16_sum(s1); s2 = row16_sum(s2);
            const float mean = s1 * (1.0f / 64.0f), var = fmaxf(s2 * (1.0f / 64.0f) - mean * mean, 0.f), rstd = __builtin_amdgcn_rsqf(var + 64e-5f);
#pragma unroll
            for (int ib = 0; ib < 4; ++ib) { const unsigned vw = (e < 2) ? vv[ib].x : vv[ib].y; const float v = (e & 1) ? bf_hi(vw) : bf_lo(vw);
                const float o = (((D[1][ib][e] - mean) * rstd) * lnw[ib] + lnb[ib] + rk4[e] * v) * bfu(gn[e][ib >> 1][ib & 1]);
                yb[loff + e * RWW + 16 * ib] = (unsigned short)(cvtpk(o, o) & 0xffffu); } }
        asm volatile("" ::: "memory");
        if (k + 1 < nsub) {
#pragma unroll
            for (int e = 0; e < 4; ++e)
#pragma unroll
                for (int ib = 0; ib < 4; ++ib) { const bf16* gb = Gt + (mb + SB) * RWW + h * 64; gn[e][ib >> 1][ib & 1] = gb[loff + e * RWW + 16 * ib]; } }
        asm volatile("" ::: "memory");
    }
    if (Sfin) store_state(Sfin, lane, S);
}
template <bool IS_P> __device__ __forceinline__ void scan_a1(const Params& p, int unit, LAS unsigned char* wb, int lane) {
    const int bh = unit / NCH, c = unit % NCH, b = bh >> 4, h = bh & 15, n = lane & 15, q = lane >> 4;
    const size_t m0 = (size_t)b * TP + (size_t)c * CH;
    const float mur = p.in[15][h * 64 + lane], muv = p.in[15][2048 + h * 64 + lane]; float pr, pv; prev_init(p, m0, h, lane, c == 0, nullptr, pr, pv);
    f4 S[4][4];
#pragma unroll
    for (int jb = 0; jb < 4; ++jb)
#pragma unroll
        for (int ib = 0; ib < 4; ++ib)
#pragma unroll
            for (int e = 0; e < 4; ++e) S[jb][ib][e] = (IS_P && ib == jb && n == 4 * q + e) ? 1.f : 0.f;
    raw_issue(p.ws, m0, h, lane, wb);
#pragma unroll 1
    for (int k = 0; k < CH / SB; ++k) {
        MS_LANDED();
        unsigned vt[8]; stage_a<false>(wb, lane, 0.f, vt, mur, muv, pr, pv);
        MS_LDS_DONE();
        if (k + 1 < CH / SB) raw_issue(p.ws, m0 + (size_t)(k + 1) * SB, h, lane, wb);
        float g[8]; { f32x16 G; gram(wb, lane, G);
#pragma unroll
            for (int r = 0; r < 8; ++r) g[r] = G[r]; } asm volatile("" ::: "memory");
        { LAS v4u* row = (LAS v4u*)(wb + D_SVT + lane * SV_PB); row[0] = (v4u){0u, 0u, 0u, 0u}; row[1] = (v4u){0u, 0u, 0u, 0u};
          if (IS_P) { row[2] = (v4u){0u, 0u, 0u, 0u}; row[3] = (v4u){0u, 0u, 0u, 0u}; } else { row[2] = (v4u){vt[0], vt[1], vt[2], vt[3]}; row[3] = (v4u){vt[4], vt[5], vt[6], vt[7]}; } }
        asm volatile("" ::: "memory");
        f4 D[1][4]; s0_products<1>(wb, lane, S, D); asm volatile("" ::: "memory");
        if (!IS_P) { const bf16x8 ar = *(const LAS bf16x8*)(wb + D_ARHS + n * XT_PB + 16 * q);
#pragma unroll
            for (int ib = 0; ib < 4; ++ib) { const bf16x8 sv = *(const LAS bf16x8*)(wb + D_SVT + (16 * ib + n) * SV_PB + 16 * q); D[0][ib] = mfma16(ar, sv, D[0][ib]); } }
        asm volatile("" ::: "memory"); solve_rows(wb, lane, D[0], g); asm volatile("" ::: "memory");
        f4 dummy[4]; update_state<false>(wb, lane, S, dummy); asm volatile("" ::: "memory");
    }
    if (!IS_P) store_state((float*)(p.ws + WS_UC) + (size_t)unit * 4096, lane, S);
    else { float* Po = (float*)(p.ws + WS_PC) + (size_t)unit * 4096;
#pragma unroll
        for (int jb = 0; jb < 4; ++jb)
#pragma unroll
            for (int ib = 0; ib < 4; ++ib)
#pragma unroll
                for (int e = 0; e < 4; ++e) Po[((jb * 4 + ib) * 64 + ((n >> 2) & 3) * 16 + 4 * q + e) * 4 + (n & 3)] = S[jb][ib][e]; }
}
__device__ __forceinline__ void scan_a(const Params& p, int unit, LAS unsigned char* wb, int lane) {
    const int bh = unit / NCH, c = unit % NCH, b = bh >> 4, h = bh & 15, n = lane & 15, q = lane >> 4;
    const size_t m0 = (size_t)b * TP + (size_t)c * CH;
    const float mur = p.in[15][h * 64 + lane], muv = p.in[15][2048 + h * 64 + lane]; float pr, pv; prev_init(p, m0, h, lane, c == 0, nullptr, pr, pv);
    f4 U[4][4], P[4][4];
#pragma unroll
    for (int jb = 0; jb < 4; ++jb)
#pragma unroll
        for (int ib = 0; ib < 4; ++ib) { U[jb][ib] = (f4){0.f, 0.f, 0.f, 0.f};
#pragma unroll
            for (int e = 0; e < 4; ++e) P[jb][ib][e] = (ib == jb && n == 4 * q + e) ? 1.f : 0.f; }
    raw_issue(p.ws, m0, h, lane, wb);
#pragma unroll 1
    for (int k = 0; k < CH / SB; ++k) {
        MS_LANDED();
        unsigned vt[8]; stage_a<false>(wb, lane, 0.f, vt, mur, muv, pr, pv);
        MS_LDS_DONE();
        if (k + 1 < CH / SB) raw_issue(p.ws, m0 + (size_t)(k + 1) * SB, h, lane, wb);
        float g[8]; { f32x16 G; gram(wb, lane, G);
#pragma unroll
            for (int r = 0; r < 8; ++r) g[r] = G[r]; } asm volatile("" ::: "memory");
        { LAS v4u* row = (LAS v4u*)(wb + D_SVT + lane * SV_PB); row[0] = (v4u){0u, 0u, 0u, 0u}; row[1] = (v4u){0u, 0u, 0u, 0u}; row[2] = (v4u){vt[0], vt[1], vt[2], vt[3]}; row[3] = (v4u){vt[4], vt[5], vt[6], vt[7]}; }
        asm volatile("" ::: "memory");
        f4 DU[1][4], DP[1][4]; s0_products<1>(wb, lane, U, DU); s0_products<1>(wb, lane, P, DP); asm volatile("" ::: "memory");
        f4 dummy[4];
        { const bf16x8 ar = *(const LAS bf16x8*)(wb + D_ARHS + n * XT_PB + 16 * q);
#pragma unroll
            for (int ib = 0; ib < 4; ++ib) { const bf16x8 sv = *(const LAS bf16x8*)(wb + D_SVT + (16 * ib + n) * SV_PB + 16 * q); DU[0][ib] = mfma16(ar, sv, DU[0][ib]); } }
        asm volatile("" ::: "memory"); solve_rows(wb, lane, DU[0], g); asm volatile("" ::: "memory");
        update_state<false>(wb, lane, U, dummy); asm volatile("" ::: "memory");
        solve_rows(wb, lane, DP[0], g); asm volatile("" ::: "memory");
        { LAS v4u* row = (LAS v4u*)(wb + D_SVT + lane * SV_PB); row[2] = (v4u){0u, 0u, 0u, 0u}; row[3] = (v4u){0u, 0u, 0u, 0u}; }
        asm volatile("" ::: "memory");
        update_state<false>(wb, lane, P, dummy);
    }
    store_state((float*)(p.ws + WS_UC) + (size_t)unit * 4096, lane, U);
    float* Po = (float*)(p.ws + WS_PC) + (size_t)unit * 4096;
#pragma unroll
    for (int jb = 0; jb < 4; ++jb)
#pragma unroll
        for (int ib = 0; ib < 4; ++ib)
#pragma unroll
            for (int e = 0; e < 4; ++e) Po[((jb * 4 + ib) * 64 + ((n >> 2) & 3) * 16 + 4 * q + e) * 4 + (n & 3)] = P[jb][ib][e];
}
}
constexpr int N_PHASES = 16;
#ifndef MK_SPLIT
#define MK_SPLIT 0
#endif
__global__ void __launch_bounds__(NWAVES * 64, 2) fwd_kernel(Params p) {
    extern __shared__ __attribute__((aligned(16))) unsigned char lds_raw[];
    LAS unsigned char* lds = (LAS unsigned char*)lds_raw;
    volatile LAS unsigned* MISC = (volatile LAS unsigned*)(lds + MISC_OFF);
    const int tid = threadIdx.x, lane = tid & 63, wave = __builtin_amdgcn_readfirstlane(tid >> 6);
    const int G = gridDim.x, gw = blockIdx.x * NWAVES + wave, NGW = G * NWAVES;
    unsigned char* ws = p.ws;
    for (int u = tid; u < (LDS_BYTES - LDSCTL_OFF) / 4; u += NWAVES * 64) ((LAS unsigned*)(lds + LDSCTL_OFF))[u] = 0u;
    __syncthreads();
    XcdBarrier bar; bar.bar = (unsigned*)(ws + WS_CTL) + CW_BAR; bar.x = 0; bar.st = nullptr;
    if (!MK_SPLIT) bar = xcd_barrier_post((unsigned*)(ws + WS_CTL) + CW_BAR, MISC + 8);
    const int lo = p.ph_lo, hi = p.ph_hi;
#define IN(k) (lo <= (k) && (k) < hi)
#define SEAM(k) do { if (IN(k) && IN((k) + 1)) xcd_barrier(bar); } while (0)
#ifndef REP_MASK
#define REP_MASK 0
#endif
#define PH_BEGIN(k) if (IN(k)) { {
#define PH_END(k) } } SEAM(k);
    using pg8::Gemm; using pg8::StaticOrderT;
    bf16* XN = (bf16*)(ws + WS_XN); bf16* HB = (bf16*)(ws + WS_H); bf16* HRES = (bf16*)(ws + WS_HRES); float* PART = (float*)(ws + WS_PART); float* SS1 = (float*)(ws + WS_CTL) + CW_SS1; float* SS2 = (float*)(ws + WS_CTL) + CW_SS2;
    const int tail_uu = ((int)blockIdx.x & 7) + 8 * (((int)blockIdx.x >> 3) / TailSO::SF);

    PH_BEGIN(0) { p0_prologue(p, lds, gw, NGW, wave, lane); }
    PH_END(0)
    PH_BEGIN(1) { Gemm g{XN, (const bf16*)(ws + WS_W1GU), M, NGU, DM}; typedef StaticOrderT<M, NGU, DM> SO; SO S; S.init((int)blockIdx.x); pg8::EpiGateUp E{HB, DFF, (const float*)(ws + WS_CTL) + CW_SS0, 0};
        pg8::gemm_phase<pg8::EpiGateUp, SO, true, true>(lds + RING_OFF, g, S, E);
        constexpr int NLONG = SO::nwg - SO::full * pg8::GRID;
        if ((int)blockIdx.x >= NLONG) { conv_w1d(p, (LAS float*)(lds + RING_OFF + wave * 16384), ((int)blockIdx.x - NLONG) * NWAVES + wave, (G - NLONG) * NWAVES, lane);
            conv_win_lora(p, (LAS float*)(lds + RING_OFF + wave * 16384), ((int)blockIdx.x - NLONG) * NWAVES + wave, (G - NLONG) * NWAVES, lane); } }
    PH_END(1)
    PH_BEGIN(2) { Gemm g{HB, (const bf16*)(ws + WS_W1D), M, DM, DFF}; typedef StaticOrderT<M, DM, DFF, true> SO; SO S; S.init((int)blockIdx.x); typedef pg8::EpiResid<true, true> EP; EP E{XN, XN, HRES, DM, 0.5f, DFF / 64, PART, tail_uu, SS1};
        pg8::gemm_phase<EP, SO, true, true>(lds + RING_OFF, g, S, E); }
    PH_END(2)
    PH_BEGIN(3) tail_combine_h(XN, 0.5f, PART, HRES, SS1, gw, NGW, lane);
    PH_END(3)
    PH_BEGIN(4) { Gemm g{HRES, (const bf16*)(ws + WS_WIN), M, NWIN, DM}; typedef StaticOrderT<M, NWIN, DM> SO; SO S; S.init((int)blockIdx.x);
        pg8::EpiWin E{(bf16*)(ws + WS_QB), p.out + O_KP, p.out + O_KS, p.out + O_VP, p.out + O_VS, (bf16*)(ws + WS_PRW), (unsigned char*)(ws + WS_GSB), (unsigned char*)(ws + WS_GRW), p.out + O_SHP, p.out + O_SHS, p.in[12], p.in[13], SS1};
        pg8::gemm_phase<pg8::EpiWin, SO, true, true>(lds + RING_OFF, g, S, E); }
    PH_END(4)
    PH_BEGIN(5) { shift_phase(p, gw, NGW, lane); }
    PH_END(5)
    PH_BEGIN(6) { Gemm g{(const bf16*)(ws + WS_ACAT), (const bf16*)(ws + WS_WLORA), M, NLORA, KLORA}; typedef pg8::LoraOrderT<M> SO; SO S; S.init((int)blockIdx.x);
        pg8::EpiLora E{(bf16*)(ws + WS_WD), (bf16*)(ws + WS_KP), (bf16*)(ws + WS_KKN), (bf16*)(ws + WS_BV), (bf16*)(ws + WS_G), (const bf16*)(ws + WS_PRW), p.in[15] + 1024, p.in[5] + 1024, p.in[16], p.in[18], p.in[21], p.in[22]};
        pg8::gemm_phase<pg8::EpiLora, SO, true, true>(lds + RING_OFF, g, S, E); }
    PH_END(6)
#if MSCAN && !defined(MS_NO_A)
    PH_BEGIN(7) { if (wave < 4) { __builtin_amdgcn_s_setprio(3);
            for (int u = (int)blockIdx.x * 4 + wave; u < 32 * NCH; u += G * 4) ms::scan_a(p, u, lds + RING_OFF + wave * ms::WAVE_BYTES, lane);
            __builtin_amdgcn_s_setprio(0); }
        attn_phase(p, wave < 4 ? lds + RING_OFF + wave * ms::WAVE_BYTES : lds + ATT2_OFF + (wave - 4) * VT_BYTES, (unsigned*)(ws + WS_CTL) + CW_ATTQ, 0, ATT_N1, lane); }
#else
    PH_BEGIN(7) { for (int u = gw; u < 32 * NCH; u += NGW) scan_pass_a(p, u, lds + RING_OFF + wave * SC_WAVE, lane); }
#endif
    PH_END(7)
    PH_BEGIN(8) {
#if MSCAN && !defined(MS_NO_C)
        if (wave < 3) __builtin_amdgcn_s_setprio(3);
        if (wave < 2) for (int u = (int)blockIdx.x * 2 + wave; u < NBS * 16; u += G * 2) { const int s = u >> 4, h = u & 15;
            ms::scan_c(p, (size_t)MPROMPT + (size_t)s * TS, h, TS / ms::SB, p.in[4] + (size_t)u * 4096, p.out + O_WKVS + (size_t)u * 4096, true, p.in[5] + (size_t)s * RWC, lds + RING_OFF + wave * ms::WAVE_BYTES, lane); }
        if (wave == 2) for (int u = blockIdx.x; u < 128; u += G) scan_pass_b(p, u, lane);
        if (wave < 3) __builtin_amdgcn_s_setprio(0);
        attn_phase(p, lds + RING_OFF + 2 * ms::WAVE_BYTES + wave * VT_BYTES, (unsigned*)(ws + WS_CTL) + CW_ATTQ + 32, ATT_N1, ATT_N2 - ATT_N1, lane);
#else
        if (wave == 0) for (int u = blockIdx.x; u < 128; u += G) scan_pass_b(p, u, lane);
        if (wave < 4) { const int vw = ((int)((blockIdx.x + G - (128 % G)) % G)) * 4 + wave;
            for (int u = vw; u < NBS * 16; u += G * 4) { const int s = u >> 4, h = u & 15;
                scan_pass_c(p, (size_t)MPROMPT + (size_t)s * TS, h, TS, p.in[4] + (size_t)u * 4096, p.out + O_WKVS + (size_t)u * 4096, lds + RING_OFF + wave * SC_WAVE, lane); } }
        attn_phase(p, lds + RING_OFF + wave * ATT_WAVE_STRIDE, (unsigned*)(ws + WS_CTL) + CW_ATTQ + 32, ATT_N1, ATT_N2 - ATT_N1, lane);
#endif
    }
    PH_END(8)
#if MSCAN && !defined(MS_NO_C)
    PH_BEGIN(9) { if (wave < 4) __builtin_amdgcn_s_setprio(3);
        if (wave < 4) for (int u = (int)blockIdx.x * 4 + wave; u < 32 * NCH; u += G * 4) { const int bh = u / NCH, c = u % NCH;
            ms::scan_c(p, (size_t)(bh >> 4) * TP + (size_t)c * CH, bh & 15, CH / ms::SB, (const float*)(ws + WS_SC) + (size_t)u * 4096, nullptr, c == 0, nullptr, lds + RING_OFF + wave * ms::WAVE_BYTES, lane); }
        if (wave < 4) __builtin_amdgcn_s_setprio(0);
        attn_phase(p, wave < 4 ? lds + RING_OFF + wave * ms::WAVE_BYTES : lds + ATT2_OFF + (wave - 4) * VT_BYTES, (unsigned*)(ws + WS_CTL) + CW_ATTQ + 64, ATT_N2, N_ATT_UNITS - ATT_N2, lane);
        if (wave >= 4) late_convert(p, (LAS float*)(lds + ATT2_OFF + (wave - 4) * VT_BYTES), (int)blockIdx.x * 4 + (wave - 4), G * 4, lane); }
#else
    PH_BEGIN(9) { for (int u = gw; u < 32 * NCH; u += NGW) { const int bh = u / NCH, c = u % NCH;
            scan_pass_c(p, (size_t)(bh >> 4) * TP + (size_t)c * CH, bh & 15, CH, (const float*)(ws + WS_SC) + (size_t)u * 4096, nullptr, lds + RING_OFF + wave * SC_WAVE, lane); } }
#endif
    PH_END(9)
    PH_BEGIN(10) { unsigned* MFLAG = (unsigned*)(ws + WS_CTL) + CW_MFLAG;
        { Gemm g{(const bf16*)(ws + WS_AO), (const bf16*)(ws + WS_WSBO), M, DM, SBW}; pg8::EpiMerge<1> E{(const unsigned char*)(ws + WS_GSB), (bf16*)(ws + WS_H), XN};
          typedef pg8::MergeOrderT<1, M, DM, SBW> SO; SO S; S.init((int)blockIdx.x, MFLAG);
          pg8::gemm_phase<pg8::EpiMerge<1>, SO, true, true>(lds + RING_OFF, g, S, E); }
        { Gemm g{(const bf16*)(ws + WS_YRW), (const bf16*)(ws + WS_WRWO), M, DM, RWW}; pg8::EpiMerge<2> E{(const unsigned char*)(ws + WS_GRW), (bf16*)(ws + WS_H), XN};
          typedef pg8::MergeOrderT<2, M, DM, RWW> SO; SO S; S.init((int)blockIdx.x, MFLAG);
          pg8::gemm_phase<pg8::EpiMerge<2>, SO, true, true>(lds + RING_OFF, g, S, E); } }
    PH_END(10)
    PH_BEGIN(11) { Gemm g{XN, (const bf16*)(ws + WS_WOUT), M, DM, DM}; typedef StaticOrderT<M, DM, DM> SO; SO S; S.init((int)blockIdx.x); typedef pg8::EpiResid<true, true> EP; EP E{HRES, HRES, HRES, DM, 1.0f, DM / 64, PART, tail_uu, SS2};
        pg8::gemm_phase<EP, SO, true, true>(lds + RING_OFF, g, S, E); }
    PH_END(11)
    PH_BEGIN(13) { Gemm g{HRES, (const bf16*)(ws + WS_W2GU), M, NGU, DM}; typedef StaticOrderT<M, NGU, DM> SO; SO S; S.init((int)blockIdx.x); pg8::EpiGateUp E{HB, DFF, SS2, 0};
        pg8::gemm_phase<pg8::EpiGateUp, SO, true, true>(lds + RING_OFF, g, S, E); }
    PH_END(13)
    PH_BEGIN(14) { Gemm g{HB, (const bf16*)(ws + WS_W2D), M, DM, DFF}; typedef StaticOrderT<M, DM, DFF, true> SO; SO S; S.init((int)blockIdx.x); typedef pg8::EpiResid<true, false> EP; EP E{HRES, HRES, p.out + O_Y, DM, 0.5f, DFF / 64, PART, tail_uu, nullptr};
        pg8::gemm_phase<EP, SO, true, true>(lds + RING_OFF, g, S, E); }
    PH_END(14)
    PH_BEGIN(15) tail_combine(HRES, 0.5f, PART, p.out + O_Y, gw, NGW, lane);
    } }
#undef IN
#undef SEAM
}

extern "C" void kernel_launch(void* const* d_in, const int* in_sizes, int n_in, void* d_out, int out_size, void* d_ws, size_t ws_size, hipStream_t stream) {
    static int grid = 0;
    if (grid == 0) {
        if (n_in != 32 || (size_t)out_size != O_END || ws_size < WS_END) { fprintf(stderr, "kernel_launch: unexpected sizes n_in %d out %d ws %zu (need %zu)\n", n_in, out_size, ws_size, (size_t)WS_END); grid = -1; return; }
        int dev = 0, cus = 0, per_cu = 0;
        if (hipGetDevice(&dev) != hipSuccess || hipDeviceGetAttribute(&cus, hipDeviceAttributeMultiprocessorCount, dev) != hipSuccess) { grid = -1; return; }
        if (hipFuncSetAttribute((const void*)fwd_kernel, hipFuncAttributeMaxDynamicSharedMemorySize, LDS_BYTES) != hipSuccess) { fprintf(stderr, "kernel_launch: hipFuncSetAttribute failed\n"); grid = -1; return; }
        if (hipOccupancyMaxActiveBlocksPerMultiprocessor(&per_cu, (const void*)fwd_kernel, NWAVES * 64, LDS_BYTES) != hipSuccess || per_cu < 1) { fprintf(stderr, "kernel_launch: occupancy query says %d\n", per_cu); (void)hipGetLastError(); per_cu = 1; }
        if (cus < pg8::GRID) { fprintf(stderr, "kernel_launch: built for a %d-CU device, found %d\n", pg8::GRID, cus); grid = -1; return; }
        grid = pg8::GRID;
    }
    if (grid < 0) return;
    if (hipMemsetAsync((char*)d_ws + WS_CTL, 0, CTL_ZERO_BYTES, stream) != hipSuccess) return;
    Params p{};
    for (int i = 0; i < 32; ++i) p.in[i] = (const float*)d_in[i];
    p.out = (float*)d_out; p.ws = (unsigned char*)d_ws;
#if MK_SPLIT
    for (int ph = 0; ph < N_PHASES; ++ph) for (int rep = 0; rep < (((REP_MASK >> ph) & 1) ? 2 : 1); ++rep) { p.ph_lo = ph; p.ph_hi = ph + 1; hipLaunchKernelGGL(fwd_kernel, dim3(grid), dim3(NWAVES * 64), LDS_BYTES, stream, p); }
#else
    p.ph_lo = 0; p.ph_hi = N_PHASES; hipLaunchKernelGGL(fwd_kernel, dim3(grid), dim3(NWAVES * 64), LDS_BYTES, stream, p);
#endif
}
```
